# Optimizing an MI355X kernel written in HIP

```python
import math
import jax, jax.numpy as jnp
from jax import lax
import numpy as np

D_MODEL = 2048
BATCH = 1
SEQ = 8192
DEPTH = 1
DEC_BATCH = 128
DEC_SEQ = 8
PAST_LEN = 16384
PAGE_SIZE = 128

N_META = 16
HEAD_DIM = 64
ATTN_WIDTH = D_MODEL // 2
N_HEADS = ATTN_WIDTH // HEAD_DIM
N_KV_HEADS = N_HEADS // 4
GQA_GROUP = N_HEADS // N_KV_HEADS
KV_WIDTH = N_KV_HEADS * HEAD_DIM
WINDOW = 128
BLOCK = 128
SSM_WIDTH = D_MODEL // 2
SSM_GROUP = 16
N_SSM_GROUPS = SSM_WIDTH // SSM_GROUP
SSM_STATE = 64
D_FF = 4 * D_MODEL
RMS_EPS = 1e-5
DT_MIN = 0.001
DT_MAX = 0.1
IN_COLS = ATTN_WIDTH + 2 * KV_WIDTH + SSM_WIDTH + 2 * D_MODEL
SPLITS = [ATTN_WIDTH, ATTN_WIDTH + KV_WIDTH, ATTN_WIDTH + 2 * KV_WIDTH, ATTN_WIDTH + 2 * KV_WIDTH + SSM_WIDTH]

kernel_name = "hybrid_swa_sink_s5_gated_step"

F32 = jnp.float32


def rmsnorm(x, g):
    xf = x.astype(F32)
    y = xf * lax.rsqrt(jnp.mean(xf * xf, axis=-1, keepdims=True) + RMS_EPS)
    return (y * g.astype(F32)).astype(x.dtype)


def alibi_slopes():
    return 2.0 ** (-8.0 * jnp.arange(1, N_HEADS + 1, dtype=F32) / N_HEADS)


def window_attend(q, k, v, q_pos, k_pos, sinks):
    s = jnp.einsum('...qkgd,...skd->...kgqs', q.astype(F32), k.astype(F32)) * (HEAD_DIM ** -0.5)
    dist = q_pos[..., :, None] - k_pos[..., None, :]
    valid = (dist >= 0) & (dist <= WINDOW) & (k_pos[..., None, :] >= 0)
    slopes = alibi_slopes().reshape(N_KV_HEADS, GQA_GROUP)[:, :, None, None]
    s = s - slopes * jnp.abs(dist).astype(F32)[..., None, None, :, :]
    s = jnp.where(valid[..., None, None, :, :], s, -jnp.inf)
    sink = sinks.astype(F32).reshape(N_KV_HEADS, GQA_GROUP)[:, :, None, None]
    m = jnp.maximum(jnp.max(s, axis=-1, keepdims=True), sink)
    p = jnp.exp(s - m)
    p = p / (jnp.sum(p, axis=-1, keepdims=True) + jnp.exp(sink - m))
    return jnp.einsum('...kgqs,...skd->...qkgd', p, v.astype(F32))


def ssm_discretize(a_re, a_im, log_dt, b_re, b_im):
    a_re = a_re.astype(F32); a_im = a_im.astype(F32)
    dt = jnp.exp(log_dt.astype(F32))[:, None]
    mag = jnp.exp(dt * a_re)
    ab_re = mag * jnp.cos(dt * a_im)
    ab_im = mag * jnp.sin(dt * a_im)
    nr = ab_re - 1.0
    ni = ab_im
    den = a_re * a_re + a_im * a_im
    fr = (nr * a_re + ni * a_im) / den
    fi = (ni * a_re - nr * a_im) / den
    b_re = b_re.astype(F32); b_im = b_im.astype(F32)
    bb_re = fr[..., None] * b_re - fi[..., None] * b_im
    bb_im = fr[..., None] * b_im + fi[..., None] * b_re
    return ab_re, ab_im, bb_re, bb_im


def ssm_scan(u, h0_re, h0_im, ab_re, ab_im, bb_re, bb_im, c_re, c_im, d):
    bu_re = jnp.einsum('gpc,ntgc->ntgp', bb_re, u)
    bu_im = jnp.einsum('gpc,ntgc->ntgp', bb_im, u)
    h0_re = h0_re.astype(F32); h0_im = h0_im.astype(F32)
    bu_re = bu_re.at[:, 0].add(ab_re * h0_re - ab_im * h0_im)
    bu_im = bu_im.at[:, 0].add(ab_re * h0_im + ab_im * h0_re)
    a_re = jnp.broadcast_to(ab_re, bu_re.shape)
    a_im = jnp.broadcast_to(ab_im, bu_im.shape)

    def combine(e1, e2):
        a1r, a1i, b1r, b1i = e1
        a2r, a2i, b2r, b2i = e2
        return (a2r * a1r - a2i * a1i,
                a2r * a1i + a2i * a1r,
                a2r * b1r - a2i * b1i + b2r,
                a2r * b1i + a2i * b1r + b2i)

    _, _, h_re, h_im = lax.associative_scan(combine, (a_re, a_im, bu_re, bu_im), axis=1)
    y = (jnp.einsum('gcp,ntgp->ntgc', c_re.astype(F32), h_re)
         - jnp.einsum('gcp,ntgp->ntgc', c_im.astype(F32), h_im)
         + d.astype(F32).reshape(N_SSM_GROUPS, SSM_GROUP) * u)
    return y, h_re[:, -1], h_im[:, -1]


def setup_inputs(seed: int = 0) -> dict:
    key = jax.random.key(seed)
    ks = jax.random.split(key, 32)
    n = lambda i, shape, scale: jax.random.normal(ks[i], shape, F32) * scale
    n_ar = jnp.arange(SSM_STATE, dtype=F32)
    return {
        "x_prompt": n(0, (BATCH, SEQ, D_MODEL), 1.0),
        "x_sample": n(1, (DEC_BATCH, DEC_SEQ, D_MODEL), 1.0),
        "cache_k": n(2, (DEC_BATCH, WINDOW, N_KV_HEADS, HEAD_DIM), 1.0),
        "cache_v": n(3, (DEC_BATCH, WINDOW, N_KV_HEADS, HEAD_DIM), 1.0),
        "state_ssm_re": n(4, (DEC_BATCH, N_SSM_GROUPS, SSM_STATE), 1.0),
        "state_ssm_im": n(5, (DEC_BATCH, N_SSM_GROUPS, SSM_STATE), 1.0),
        "meta_tokens": n(6, (N_META, D_MODEL), 1.0),
        "g_attn_norm": 1.0 + n(7, (D_MODEL,), 0.02),
        "w_in": n(8, (D_MODEL, IN_COLS), D_MODEL ** -0.5),
        "sinks": n(9, (N_HEADS,), 0.5),
        "ssm_a_re": -0.5 + n(10, (N_SSM_GROUPS, SSM_STATE), 0.01),
        "ssm_a_im": math.pi * n_ar[None, :] + n(11, (N_SSM_GROUPS, SSM_STATE), 0.01),
        "ssm_log_dt": jax.random.uniform(ks[12], (N_SSM_GROUPS,), F32, math.log(DT_MIN), math.log(DT_MAX)),
        "ssm_b_re": n(13, (N_SSM_GROUPS, SSM_STATE, SSM_GROUP), (2.0 * SSM_GROUP) ** -0.5),
        "ssm_b_im": n(14, (N_SSM_GROUPS, SSM_STATE, SSM_GROUP), (2.0 * SSM_GROUP) ** -0.5),
        "ssm_c_re": n(15, (N_SSM_GROUPS, SSM_GROUP, SSM_STATE), (2.0 * SSM_STATE) ** -0.5),
        "ssm_c_im": n(16, (N_SSM_GROUPS, SSM_GROUP, SSM_STATE), (2.0 * SSM_STATE) ** -0.5),
        "ssm_d": n(17, (SSM_WIDTH,), 1.0),
        "w_glu": n(18, (SSM_WIDTH, SSM_WIDTH), SSM_WIDTH ** -0.5),
        "b_glu": n(19, (SSM_WIDTH,), 0.02),
        "w_attn_branch": n(20, (ATTN_WIDTH, D_MODEL), ATTN_WIDTH ** -0.5),
        "w_ssm_branch": n(21, (SSM_WIDTH, D_MODEL), SSM_WIDTH ** -0.5),
        "w_out": n(22, (D_MODEL, D_MODEL), D_MODEL ** -0.5),
        "g_mlp_norm": 1.0 + n(23, (D_MODEL,), 0.02),
        "w_up": n(24, (D_MODEL, D_FF), D_MODEL ** -0.5),
        "w_down": n(25, (D_FF, D_MODEL), D_FF ** -0.5),
        "g_final_norm": 1.0 + n(26, (D_MODEL,), 0.02),
    }


def reference(x_prompt, x_sample, cache_k, cache_v, state_ssm_re, state_ssm_im,
              meta_tokens, g_attn_norm, w_in, sinks, ssm_a_re, ssm_a_im, ssm_log_dt,
              ssm_b_re, ssm_b_im, ssm_c_re, ssm_c_im, ssm_d, w_glu, b_glu,
              w_attn_branch, w_ssm_branch, w_out, g_mlp_norm, w_up, w_down, g_final_norm):
    ab_re, ab_im, bb_re, bb_im = ssm_discretize(ssm_a_re, ssm_a_im, ssm_log_dt, ssm_b_re, ssm_b_im)

    def layer(x, attend, h0_re, h0_im):
        nb, t, _ = x.shape
        h = rmsnorm(x, g_attn_norm)
        proj = h @ w_in
        q, k, v, u, gates = jnp.split(proj, SPLITS, axis=-1)
        q = q.reshape(nb, t, N_KV_HEADS, GQA_GROUP, HEAD_DIM)
        k = k.reshape(nb, t, N_KV_HEADS, HEAD_DIM)
        v = v.reshape(nb, t, N_KV_HEADS, HEAD_DIM)
        a = attend(q, k, v)
        us = u.astype(F32).reshape(nb, t, N_SSM_GROUPS, SSM_GROUP)
        ys, hr, hi = ssm_scan(us, h0_re, h0_im, ab_re, ab_im, bb_re, bb_im, ssm_c_re, ssm_c_im, ssm_d)
        z = jax.nn.gelu(ys.reshape(nb, t, SSM_WIDTH))
        s = z * jax.nn.sigmoid(z @ w_glu.astype(F32) + b_glu.astype(F32))
        g_a, g_s = jnp.split(jax.nn.sigmoid(gates.astype(F32)), 2, axis=-1)
        merged = g_a * (a @ w_attn_branch.astype(F32)) + g_s * (s @ w_ssm_branch.astype(F32))
        x = x + merged.astype(x.dtype) @ w_out
        hm = rmsnorm(x, g_mlp_norm)
        x = x + jnp.square(jax.nn.relu(hm @ w_up)) @ w_down
        return x, k, v, hr, hi

    def attend_prompt(q, k, v):
        nb, t = q.shape[:2]
        pad = (-t) % BLOCK
        n_blk = (t + pad) // BLOCK
        padf = lambda arr: jnp.pad(arr, ((0, 0), (pad, 0)) + ((0, 0),) * (arr.ndim - 2))
        qb = padf(q).reshape(nb, n_blk, BLOCK, N_KV_HEADS, GQA_GROUP, HEAD_DIM)
        kb = padf(k).reshape(nb, n_blk, BLOCK, N_KV_HEADS, HEAD_DIM)
        vb = padf(v).reshape(nb, n_blk, BLOCK, N_KV_HEADS, HEAD_DIM)
        with_prev = lambda arr: jnp.concatenate(
            [jnp.concatenate([jnp.zeros_like(arr[:, :1]), arr[:, :-1]], axis=1), arr], axis=2)
        pos = (jnp.arange(n_blk * BLOCK, dtype=jnp.int32) - pad).reshape(n_blk, BLOCK)
        k_pos = jnp.concatenate([pos - BLOCK, pos], axis=-1)
        o = window_attend(qb, with_prev(kb), with_prev(vb), pos, k_pos, sinks)
        return o.reshape(nb, n_blk * BLOCK, ATTN_WIDTH)[:, pad:]

    def attend_sample(q, k, v):
        nb, t = q.shape[:2]
        w = cache_k.shape[1]
        kk = jnp.concatenate([cache_k.astype(k.dtype), k], axis=1)
        vv = jnp.concatenate([cache_v.astype(v.dtype), v], axis=1)
        q_pos = PAST_LEN + jnp.arange(t, dtype=jnp.int32)
        k_pos = jnp.concatenate([PAST_LEN - w + jnp.arange(w, dtype=jnp.int32), q_pos])
        o = window_attend(q, kk, vv, q_pos, k_pos, sinks)
        return o.reshape(nb, t, ATTN_WIDTH)

    bp = x_prompt.shape[0]
    meta = jnp.broadcast_to(meta_tokens.astype(x_prompt.dtype)[None], (bp, N_META, D_MODEL))
    xp = jnp.concatenate([meta, x_prompt], axis=1)
    zeros_state = jnp.zeros((bp, N_SSM_GROUPS, SSM_STATE), F32)
    for _ in range(DEPTH):
        xp, kp, vp, hrp, hip = layer(xp, attend_prompt, zeros_state, zeros_state)
    y_prompt = rmsnorm(xp, g_final_norm)[:, N_META:]
    k_prompt = kp[:, -WINDOW:]
    v_prompt = vp[:, -WINDOW:]
    ssm_re_prompt = hrp.astype(state_ssm_re.dtype)
    ssm_im_prompt = hip.astype(state_ssm_im.dtype)

    xs = x_sample
    for _ in range(DEPTH):
        xs, ks_new, vs_new, hrs, his = layer(xs, attend_sample, state_ssm_re, state_ssm_im)
    y_sample = rmsnorm(xs, g_final_norm)
    k_sample = jnp.concatenate([cache_k.astype(ks_new.dtype), ks_new], axis=1)[:, -WINDOW:]
    v_sample = jnp.concatenate([cache_v.astype(vs_new.dtype), vs_new], axis=1)[:, -WINDOW:]
    ssm_re_sample = hrs.astype(state_ssm_re.dtype)
    ssm_im_sample = his.astype(state_ssm_im.dtype)

    return (y_prompt, y_sample, k_prompt, v_prompt, ssm_re_prompt, ssm_im_prompt,
            k_sample, v_sample, ssm_re_sample, ssm_im_sample)
```

```cpp
#include <hip/hip_runtime.h>
#include <hip/hip_cooperative_groups.h>
#include <cstdio>
#include <cstdint>
namespace cg = cooperative_groups;
namespace pg8 {
#define PG8_LAS __attribute__((address_space(3)))
typedef unsigned short bf16_t;
typedef short bf16x8 __attribute__((ext_vector_type(8)));
typedef float f32x4 __attribute__((ext_vector_type(4)));
typedef unsigned u32x4 __attribute__((ext_vector_type(4)));
constexpr int BM = 256, BK = 64, HALF = 128, HTB = HALF * BK * 2  , STAGE_BYTES = 8 * HTB, NXCD = 8, WGM = 8;

__host__ __device__ __forceinline__ int lds_byte(int r, int c) { const int st = (r >> 4) * 2 + (c >> 5), rr = r & 15, cc = c & 31, ob = rr * 64 + cc * 2; return st * 1024 + (ob ^ (((ob >> 9) & 1) << 5)); }
__host__ __device__ __forceinline__ void stage_rc(int b, int& R, int& C) { const int st = b / 1024, sb = b % 1024, swz = sb ^ (((sb >> 9) & 1) << 5); R = (st >> 1) * 16 + swz / 64; C = (st & 1) * 32 + (swz % 64) / 2; }
__host__ __device__ __forceinline__ int perm32(int rho) { const int n = rho >> 4, i = rho & 15; return 8 * (i >> 2) + 4 * n + (i & 3); }

struct Unit { int pm, pn; };
struct Gemm { const bf16_t* A; const bf16_t* Bt; int M, N, K; };

struct StaticOrder {
    int nM, nN, nwg, G, c;
    __host__ __device__ void init(int M, int N, int G_, int c_) { nM = M / BM; nN = N / BM; nwg = nM * nN; G = G_; c = c_; }
    __host__ __device__ bool next(int i, Unit& u) const {
        const long L = (long)i * G + c; if (L >= nwg) return false;
        int wgid = (int)L; { const int q = nwg / NXCD, r = nwg % NXCD, xcd = wgid % NXCD, off = wgid / NXCD; wgid = (xcd < r ? xcd * (q + 1) : r * (q + 1) + (xcd - r) * q) + off; }
        const int nig = WGM * nN, gid = wgid / nig, fm = gid * WGM, gsz = (nM - fm) < WGM ? (nM - fm) : WGM;
        u.pm = fm + ((wgid % nig) % gsz); u.pn = (wgid % nig) / gsz; return true;
    }
    __device__ __forceinline__ void a_ready(const Unit&) const {}
    __device__ __forceinline__ void done(const Unit&) const {}
};
template <class Epi, class Sched, bool ALIGN_EPI = false, bool SP2 = false>
__device__ __forceinline__ void gemm_phase(PG8_LAS unsigned char* lds, const Gemm g, const Sched& S, const Epi& E) {
    const int tid = threadIdx.x, wid = __builtin_amdgcn_readfirstlane(tid >> 6), lane = tid & 63, wr = wid >> 2, wc = wid & 3, fr = lane & 15, fq = lane >> 4;
    const int K = g.K, nt = K / BK;
    unsigned voffA[2], voffB[2];
#pragma unroll
    for (int i = 0; i < 2; ++i) { int R, C; stage_rc(tid * 16 + i * 8192, R, C); const int Rb = Epi::PERM ? ((R & ~31) + perm32(R & 31)) : R;
        voffA[i] = (unsigned)(R * K + C) * 2u; voffB[i] = (unsigned)(Rb * K + C) * 2u; }
    const size_t kstep = (size_t)(BK * 2);
    const size_t hstep = (size_t)HALF * K * 2;
    const size_t tstep = 2 * hstep;
    const unsigned ldsw = (unsigned)wid * 1024u;
    const int aoff = lds_byte(wr * 64 + fr, fq * 8), boff = lds_byte(wc * 32 + fr, fq * 8);
#define PG8_SA(b, h) (((b) * 2 + (h)) * HTB)
#define PG8_SB(b, h) ((4 + (b) * 2 + (h)) * HTB)
#define PG8_STAGE(bufoff, gbase, voff) do { _Pragma("unroll") for (int _i = 0; _i < 2; ++_i) \
        __builtin_amdgcn_global_load_lds((const unsigned*)((const char*)(gbase) + (voff)[_i]), (PG8_LAS unsigned*)(lds + (bufoff) + ldsw + _i * 8192), 16, 0, 0); } while (0)
#define PG8_LDA(dst, b, h) do { _Pragma("unroll") for (int m = 0; m < 4; ++m) _Pragma("unroll") for (int k = 0; k < 2; ++k) dst[m][k] = *(const PG8_LAS bf16x8*)(lds + PG8_SA(b, h) + aoff + m * 2048 + k * 1024); } while (0)
#define PG8_LDB(dst, b, h) do { _Pragma("unroll") for (int n = 0; n < 2; ++n) _Pragma("unroll") for (int k = 0; k < 2; ++k) dst[n][k] = *(const PG8_LAS bf16x8*)(lds + PG8_SB(b, h) + boff + n * 2048 + k * 1024); } while (0)
#define PG8_MMA(ai, bj, At, Bt) do { __builtin_amdgcn_s_setprio(1); _Pragma("unroll") for (int m = 0; m < 4; ++m) _Pragma("unroll") for (int n = 0; n < 2; ++n) _Pragma("unroll") for (int k = 0; k < 2; ++k) \
        acc[ai][bj][m][n] = __builtin_amdgcn_mfma_f32_16x16x32_bf16(Bt[n][k], At[m][k], acc[ai][bj][m][n], 0, 0, 0); __builtin_amdgcn_s_setprio(0); } while (0)
#define PG8_WAIT_V(n) asm volatile("s_waitcnt vmcnt(" #n ")" ::: "memory")
#define PG8_WAIT_L(n) asm volatile("s_waitcnt lgkmcnt(" #n ")" ::: "memory")
#define PG8_BAR __builtin_amdgcn_s_barrier()
#define PG8_SCHED __builtin_amdgcn_sched_barrier(0)
    Unit cur, nxt; int ui = 0;
    if (!S.next(0, cur)) return;
    f32x4 acc[2][2][4][2];
#pragma unroll
    for (int a = 0; a < 2; ++a)
#pragma unroll
        for (int b = 0; b < 2; ++b)
#pragma unroll
            for (int m = 0; m < 4; ++m)
#pragma unroll
                for (int n = 0; n < 2; ++n) acc[a][b][m][n] = (f32x4){0.f, 0.f, 0.f, 0.f};
    bf16x8 At[4][2], B0[2][2], B1[2][2];
    const char* cA = (const char*)g.A + (size_t)cur.pm * tstep; const char* cB = (const char*)g.Bt + (size_t)cur.pn * tstep;
    S.a_ready(cur);
    if constexpr (SP2) {
        PG8_STAGE(PG8_SB(0, 0), cB, voffB); PG8_STAGE(PG8_SB(0, 1), cB + hstep, voffB); PG8_STAGE(PG8_SA(0, 0), cA, voffA); PG8_STAGE(PG8_SA(0, 1), cA + hstep, voffA);
        if (wr == 1) PG8_BAR;
        PG8_WAIT_V(2); PG8_BAR;
        PG8_STAGE(PG8_SB(1, 0), cB + kstep, voffB); PG8_STAGE(PG8_SA(1, 0), cA + kstep, voffA); PG8_STAGE(PG8_SB(1, 1), cB + hstep + kstep, voffB);
        PG8_WAIT_V(6); PG8_BAR;
    } else {
        PG8_STAGE(PG8_SB(0, 0), cB, voffB); PG8_STAGE(PG8_SA(0, 0), cA, voffA); PG8_STAGE(PG8_SB(0, 1), cB + hstep, voffB); PG8_STAGE(PG8_SA(0, 1), cA + hstep, voffA);
        if (wr == 1) PG8_BAR;
        PG8_WAIT_V(4); PG8_BAR;
        PG8_STAGE(PG8_SB(1, 0), cB + kstep, voffB); PG8_STAGE(PG8_SA(1, 0), cA + kstep, voffA); PG8_STAGE(PG8_SB(1, 1), cB + hstep + kstep, voffB);
        PG8_WAIT_V(6); PG8_BAR;
    }
    for (;;) {
        const bool has_next = S.next(ui + 1, nxt);
        const char* nA = has_next ? (const char*)g.A + (size_t)nxt.pm * tstep : cA; const char* nB = has_next ? (const char*)g.Bt + (size_t)nxt.pn * tstep : cB;
        for (int t = 0; t < nt; t += 2) {
            const bool last = (t == nt - 2);
            const char* a1 = cA + (size_t)(t + 1) * kstep;
            const char* a2 = last ? nA : cA + (size_t)(t + 2) * kstep; const char* b2 = last ? nB : cB + (size_t)(t + 2) * kstep;
            const char* a3 = a2 + kstep; const char* b3 = b2 + kstep;
            if (last && has_next) S.a_ready(nxt);
            if constexpr (SP2) {
            PG8_LDB(B0, 0, 0); PG8_LDB(B1, 0, 1); PG8_SCHED; PG8_LDA(At, 0, 0); PG8_STAGE(PG8_SA(1, 1), a1 + hstep, voffA);
            PG8_WAIT_V(8); PG8_WAIT_L(0); PG8_BAR; PG8_MMA(0, 0, At, B0); PG8_MMA(0, 1, At, B1); PG8_BAR; PG8_SCHED;
            PG8_LDA(At, 0, 1); PG8_STAGE(PG8_SB(0, 0), b2, voffB); PG8_STAGE(PG8_SB(0, 1), b2 + hstep, voffB); PG8_STAGE(PG8_SA(0, 0), a2, voffA);
            PG8_WAIT_V(8); PG8_WAIT_L(0); PG8_BAR; PG8_MMA(1, 0, At, B0); PG8_MMA(1, 1, At, B1); PG8_BAR; PG8_SCHED;
            PG8_LDB(B0, 1, 0); PG8_LDB(B1, 1, 1); PG8_SCHED; PG8_LDA(At, 1, 0); PG8_STAGE(PG8_SA(0, 1), a2 + hstep, voffA);
            PG8_WAIT_V(8); PG8_WAIT_L(0); PG8_BAR; PG8_MMA(0, 0, At, B0); PG8_MMA(0, 1, At, B1); PG8_BAR; PG8_SCHED;
            PG8_LDA(At, 1, 1); PG8_STAGE(PG8_SB(1, 0), b3, voffB); PG8_STAGE(PG8_SB(1, 1), b3 + hstep, voffB); PG8_STAGE(PG8_SA(1, 0), a3, voffA);
            PG8_WAIT_V(8); PG8_WAIT_L(0); PG8_BAR; PG8_MMA(1, 0, At, B0); PG8_MMA(1, 1, At, B1); PG8_BAR; PG8_SCHED;
            } else {
            PG8_LDB(B0, 0, 0); PG8_SCHED; PG8_LDA(At, 0, 0); PG8_STAGE(PG8_SA(1, 1), a1 + hstep, voffA);
            PG8_WAIT_L(8); PG8_BAR; PG8_WAIT_L(0); PG8_MMA(0, 0, At, B0); PG8_BAR; PG8_SCHED;
            PG8_LDB(B1, 0, 1); PG8_STAGE(PG8_SB(0, 0), b2, voffB);
            PG8_BAR; PG8_WAIT_L(0); PG8_MMA(0, 1, At, B1); PG8_BAR;
            PG8_LDA(At, 0, 1); PG8_STAGE(PG8_SA(0, 0), a2, voffA);
            PG8_BAR; PG8_WAIT_L(0); PG8_MMA(1, 0, At, B0); PG8_BAR; PG8_SCHED;
            PG8_STAGE(PG8_SB(0, 1), b2 + hstep, voffB);
            PG8_WAIT_V(6); PG8_BAR; PG8_MMA(1, 1, At, B1); PG8_BAR;
            PG8_LDB(B0, 1, 0); PG8_SCHED; PG8_LDA(At, 1, 0); PG8_STAGE(PG8_SA(0, 1), a2 + hstep, voffA);
            PG8_WAIT_L(8); PG8_BAR; PG8_WAIT_L(0); PG8_MMA(0, 0, At, B0); PG8_BAR; PG8_SCHED;
            PG8_LDB(B1, 1, 1); PG8_STAGE(PG8_SB(1, 0), b3, voffB);
            PG8_BAR; PG8_WAIT_L(0); PG8_MMA(0, 1, At, B1); PG8_BAR;
            PG8_LDA(At, 1, 1); PG8_STAGE(PG8_SA(1, 0), a3, voffA);
            PG8_BAR; PG8_WAIT_L(0); PG8_MMA(1, 0, At, B0); PG8_BAR; PG8_SCHED;
            PG8_STAGE(PG8_SB(1, 1), b3 + hstep, voffB);
            PG8_WAIT_V(6); PG8_BAR; PG8_MMA(1, 1, At, B1); PG8_BAR;
            }
        }
        if constexpr (ALIGN_EPI) { if (wr == 0) PG8_BAR; }
        if constexpr (!Epi::AFTER_DRAIN) { E(acc, cur, wr, wc, fr, fq); S.done(cur); }
        if (!has_next) break;
#pragma unroll
        for (int a = 0; a < 2; ++a)
#pragma unroll
            for (int b = 0; b < 2; ++b)
#pragma unroll
                for (int m = 0; m < 4; ++m)
#pragma unroll
                    for (int n = 0; n < 2; ++n) acc[a][b][m][n] = (f32x4){0.f, 0.f, 0.f, 0.f};
        cur = nxt; cA = nA; cB = nB; ++ui;
        if constexpr (ALIGN_EPI) { if (wr == 1) PG8_BAR; }
    }
    PG8_WAIT_V(0);
    if constexpr (!ALIGN_EPI) { if (wr == 0) PG8_BAR; }
    PG8_BAR;
    if constexpr (Epi::AFTER_DRAIN) { E.fused(acc, cur, wr, wc, fr, fq, lds, wid, lane); S.done(cur); }
#undef PG8_SA
#undef PG8_SB
#undef PG8_STAGE
#undef PG8_LDA
#undef PG8_LDB
#undef PG8_MMA
#undef PG8_WAIT_V
#undef PG8_WAIT_L
#undef PG8_BAR
#undef PG8_SCHED
}
}

using pg8::bf16_t; using pg8::bf16x8; using pg8::f32x4; using pg8::u32x4;
#define LAS __attribute__((address_space(3)))
typedef float f32x2 __attribute__((ext_vector_type(2)));
typedef unsigned u32x2 __attribute__((ext_vector_type(2)));
typedef __bf16 bf16x2_t __attribute__((ext_vector_type(2)));

constexpr int DM = 2048, AW = 1024, KVW = 256, INC = 6656, DFF = 8192;
constexpr int M2 = 9216, M1 = 9232, MP = 9472;
constexpr int PAST = 16384;
constexpr size_t O_Y = 0, O_KP = 18874368, O_VP = 18907136, O_SRP = 18939904, O_SIP = 18944000, O_KS = 18948096, O_VS = 23142400, O_SRS = 27336704, O_SIS = 27860992;
constexpr size_t WS_AB = 0;
constexpr size_t WS_BB = 32768;
constexpr size_t WS_E = WS_BB + 524288;
constexpr size_t WS_WIN = 8388608;
constexpr size_t WS_WGLU = WS_WIN + (size_t)INC * DM * 2;
constexpr size_t WS_WA = WS_WGLU + (size_t)1024 * 1024 * 2;
constexpr size_t WS_WS = WS_WA + (size_t)2048 * 1024 * 2;
constexpr size_t WS_WOUT = WS_WS + (size_t)2048 * 1024 * 2;
constexpr size_t WS_WUP = WS_WOUT + (size_t)2048 * 2048 * 2;
constexpr size_t WS_WDN = WS_WUP + (size_t)DFF * DM * 2;
constexpr size_t WS_H = WS_WDN + (size_t)DFF * DM * 2;
constexpr size_t WS_R = WS_H + (size_t)MP * DM * 2;
constexpr size_t WS_Q = WS_R;
constexpr size_t WS_K = WS_Q + (size_t)MP * 1024 * 2;
constexpr size_t WS_V = WS_K + (size_t)MP * 256 * 2;
constexpr size_t WS_U = WS_V + (size_t)MP * 256 * 2;
constexpr size_t WS_G = WS_U + (size_t)MP * 1024 * 4;
constexpr size_t WS_Z = WS_G + (size_t)MP * 4096 * 2;
constexpr size_t WS_END = WS_Z + (size_t)MP * 1024 * 2;
constexpr size_t WS_ACT = WS_R;
static_assert(WS_ACT + (size_t)M2 * DFF * 2 <= WS_END, "act overlay");
static_assert(WS_E + (size_t)129 * 4096 * 8 <= WS_WIN, "ssm scratch");

constexpr int LDS_BYTES = 135168;

struct Params { const float* in[27]; float* out; unsigned char* ws; };

__device__ __forceinline__ unsigned pk2(float lo, float hi) { f32x2 v = {lo, hi}; bf16x2_t b = __builtin_convertvector(v, bf16x2_t); return __builtin_bit_cast(unsigned, b); }
__device__ __forceinline__ u32x4 pk8(f32x4 a, f32x4 b) { u32x4 w; w.x = pk2(a[0], a[1]); w.y = pk2(a[2], a[3]); w.z = pk2(b[0], b[1]); w.w = pk2(b[2], b[3]); return w; }
__device__ __forceinline__ float bf_lo(unsigned w) { return __builtin_bit_cast(float, w << 16); }
__device__ __forceinline__ float bf_hi(unsigned w) { return __builtin_bit_cast(float, w & 0xffff0000u); }
__device__ __forceinline__ void unpk8(u32x4 w, f32x4& a, f32x4& b) { a = (f32x4){bf_lo(w.x), bf_hi(w.x), bf_lo(w.y), bf_hi(w.y)}; b = (f32x4){bf_lo(w.z), bf_hi(w.z), bf_lo(w.w), bf_hi(w.w)}; }
__device__ __forceinline__ float sigmoidf_(float x) { return __builtin_amdgcn_rcpf(1.f + __expf(-x)); }
__device__ __forceinline__ f32x4 sig4(f32x4 v) { return (f32x4){sigmoidf_(v[0]), sigmoidf_(v[1]), sigmoidf_(v[2]), sigmoidf_(v[3])}; }
__device__ __forceinline__ float gelu_tanh(float x) { const float t = 1.5957691216057308f * (x + 0.044715f * x * x * x); return x * sigmoidf_(t); }
__device__ __forceinline__ float wave_sum(float v) {
#pragma unroll
    for (int o = 1; o < 64; o <<= 1) v += __shfl_xor(v, o);
    return v;
}
#define LDS_WAIT() asm volatile("s_waitcnt lgkmcnt(0)" ::: "memory")

template <class F> struct Epi {
    static constexpr bool PERM = true, AFTER_DRAIN = false;
    F f;
    __device__ __forceinline__ void operator()(const f32x4 (&acc)[2][2][4][2], const pg8::Unit& u, int wr, int wc, int fr, int fq) const {
        const int row0 = u.pm * 256 + wr * 64 + fr, col0 = u.pn * 256 + wc * 32 + 8 * fq;
#pragma unroll
        for (int ai = 0; ai < 2; ++ai)
#pragma unroll
            for (int m = 0; m < 4; ++m)
#pragma unroll
                for (int bj = 0; bj < 2; ++bj) f(row0 + ai * 128 + m * 16, col0 + bj * 128, acc[ai][bj][m][0], acc[ai][bj][m][1]);
    }
};
struct F1 {
    bf16_t *Q, *Kb, *Vb, *G; float* U; float* out;
    __device__ __forceinline__ void operator()(int row, int col, f32x4 v0, f32x4 v1) const {
        if (col < 1024) { *(u32x4*)(Q + (size_t)row * 1024 + col) = pk8(v0 * 0.125f, v1 * 0.125f); }
        else if (col < 1536) {
            const bool isv = col >= 1280; const int c = col - (isv ? 1280 : 1024);
            *(u32x4*)((isv ? Vb : Kb) + (size_t)row * 256 + c) = pk8(v0, v1);
            float* o = nullptr;
            if (row >= 8064 && row < 8192) o = out + (isv ? O_VP : O_KP) + (size_t)(row - 8064) * 256 + c;
            else if (row >= 8192 && row < 9216) { const int b = (row - 8192) >> 3, i = (row - 8192) & 7; o = out + (isv ? O_VS : O_KS) + (size_t)(b * 128 + 120 + i) * 256 + c; }
            if (o) { *(f32x4*)o = v0; *(f32x4*)(o + 4) = v1; }
        } else if (col < 2560) { float* o = U + (size_t)row * 1024 + (col - 1536); *(f32x4*)o = v0; *(f32x4*)(o + 4) = v1; }
        else { *(u32x4*)(G + (size_t)row * 4096 + (col - 2560)) = pk8(sig4(v0), sig4(v1)); }
    }
};
struct F4 {
    const bf16_t* Z; const float* bias; bf16_t* S;
    __device__ __forceinline__ void operator()(int row, int col, f32x4 v0, f32x4 v1) const {
        f32x4 z0, z1; unpk8(*(const u32x4*)(Z + (size_t)row * 1024 + col), z0, z1);
        const f32x4 b0 = *(const f32x4*)(bias + col), b1 = *(const f32x4*)(bias + col + 4);
        *(u32x4*)(S + (size_t)row * 1024 + col) = pk8(z0 * sig4(v0 + b0), z1 * sig4(v1 + b1));
    }
};
struct F5a {
    const bf16_t* G; float* T;
    __device__ __forceinline__ void operator()(int row, int col, f32x4 v0, f32x4 v1) const {
        f32x4 g0, g1; unpk8(*(const u32x4*)(G + (size_t)row * 4096 + col), g0, g1);
        float* o = T + (size_t)row * 2048 + col; *(f32x4*)o = g0 * v0; *(f32x4*)(o + 4) = g1 * v1;
    }
};
struct F5b {
    const bf16_t* G; const float* T; bf16_t* Mg;
    __device__ __forceinline__ void operator()(int row, int col, f32x4 v0, f32x4 v1) const {
        f32x4 g0, g1; unpk8(*(const u32x4*)(G + (size_t)row * 4096 + 2048 + col), g0, g1);
        const float* t = T + (size_t)row * 2048 + col; const f32x4 t0 = *(const f32x4*)t, t1 = *(const f32x4*)(t + 4);
        *(u32x4*)(Mg + (size_t)row * 2048 + col) = pk8(t0 + g0 * v0, t1 + g1 * v1);
    }
};
struct F6 {
    const float *xp, *xs; float* X;
    __device__ __forceinline__ void operator()(int row, int col, f32x4 v0, f32x4 v1) const {
        const float* x = (row < 8192 ? xp + (size_t)row * 2048 : xs + (size_t)(row - 8192) * 2048) + col;
        float* o = X + (size_t)row * 2048 + col; *(f32x4*)o = *(const f32x4*)x + v0; *(f32x4*)(o + 4) = *(const f32x4*)(x + 4) + v1;
    }
};
struct F8 {
    bf16_t* ACT;
    __device__ __forceinline__ void operator()(int row, int col, f32x4 v0, f32x4 v1) const {
        const f32x4 z = {0.f, 0.f, 0.f, 0.f}; f32x4 a = __builtin_elementwise_max(v0, z), b = __builtin_elementwise_max(v1, z);
        *(u32x4*)(ACT + (size_t)row * DFF + col) = pk8(a * a, b * b);
    }
};
struct F9 {
    float* X;
    __device__ __forceinline__ void operator()(int row, int col, f32x4 v0, f32x4 v1) const {
        float* o = X + (size_t)row * 2048 + col; *(f32x4*)o = *(const f32x4*)o + v0; *(f32x4*)(o + 4) = *(const f32x4*)(o + 4) + v1;
    }
};

__device__ __forceinline__ void transpose_item(const float* __restrict__ W, int K, int N, bf16_t* WT, LAS float* scr, int item, int lane) {
    const int nblk = N / 32, kb = item / nblk, nb = item % nblk, k0 = 64 * kb, n0 = 32 * nb;
#pragma unroll 8
    for (int i = 0; i < 32; ++i) { const int kk = 2 * i + (lane >> 5); scr[kk * 33 + (lane & 31)] = W[(size_t)(k0 + kk) * N + n0 + (lane & 31)]; }
    LDS_WAIT();
    const int c = lane & 7;
#pragma unroll
    for (int j = 0; j < 4; ++j) { const int n = (lane >> 3) + 8 * j; const LAS float* s = scr + (8 * c) * 33 + n;
        u32x4 o; o.x = pk2(s[0 * 33], s[1 * 33]); o.y = pk2(s[2 * 33], s[3 * 33]); o.z = pk2(s[4 * 33], s[5 * 33]); o.w = pk2(s[6 * 33], s[7 * 33]);
        *(u32x4*)(WT + (size_t)(n0 + n) * K + k0 + 8 * c) = o; }
    LDS_WAIT();
}
__device__ __forceinline__ void rms_row(const float* xrow, const float* __restrict__ g, bf16_t* ob, float* of, int lane) {
    f32x4 v[8]; float s = 0.f;
#pragma unroll
    for (int j = 0; j < 8; ++j) { v[j] = ((const f32x4*)xrow)[64 * j + lane]; s += (v[j][0] * v[j][0] + v[j][1] * v[j][1]) + (v[j][2] * v[j][2] + v[j][3] * v[j][3]); }
    const float rstd = 1.f / sqrtf(wave_sum(s) * (1.f / 2048.f) + 1e-5f);
#pragma unroll
    for (int j = 0; j < 8; ++j) { const f32x4 gg = ((const f32x4*)g)[64 * j + lane]; const f32x4 y = v[j] * rstd * gg;
        if (ob) ((u32x2*)ob)[64 * j + lane] = (u32x2){pk2(y[0], y[1]), pk2(y[2], y[3])}; else ((f32x4*)of)[64 * j + lane] = y; }
}

constexpr int KS_PITCH = 144, VT_PITCH = 424, LDS_VT_OFF = 192 * KS_PITCH;
__device__ __forceinline__ void attn_unit(const Params& P, int unit, LAS unsigned char* lds, int tid, int wave, int lane) {
    bf16_t* Qb = (bf16_t*)(P.ws + WS_Q); const bf16_t* Kb = (const bf16_t*)(P.ws + WS_K); const bf16_t* Vb = (const bf16_t*)(P.ws + WS_V);
    const bool sample = (unit & 1); const int kvh = (unit >> 1) & 3, blk = unit >> 3;
    LAS unsigned char* Ks = lds; LAS unsigned char* Vt = lds + LDS_VT_OFF;
    for (int idx = tid; idx < 192 * 8; idx += 512) {
        const int key = idx >> 3, ch = idx & 7;
        u32x4 kv = {0u, 0u, 0u, 0u}, vv = {0u, 0u, 0u, 0u};
        if (!sample) {
            const int pos = 64 * blk - 112 + key;
            if (pos >= 0) { const int row = pos < 16 ? 9216 + pos : pos - 16; kv = *(const u32x4*)(Kb + (size_t)row * 256 + kvh * 64 + ch * 8); vv = *(const u32x4*)(Vb + (size_t)row * 256 + kvh * 64 + ch * 8); }
        } else if (key < 128) {
            const size_t o = ((size_t)(blk * 128 + key) * 4 + kvh) * 64 + ch * 8;
            const float* pk = P.in[2] + o; const float* pv = P.in[3] + o;
            kv = pk8(*(const f32x4*)pk, *(const f32x4*)(pk + 4)); vv = pk8(*(const f32x4*)pv, *(const f32x4*)(pv + 4));
        } else if (key < 136) {
            const int row = 8192 + 8 * blk + key - 128; kv = *(const u32x4*)(Kb + (size_t)row * 256 + kvh * 64 + ch * 8); vv = *(const u32x4*)(Vb + (size_t)row * 256 + kvh * 64 + ch * 8);
        }
        *(LAS u32x4*)(Ks + key * KS_PITCH + ch * 16) = kv;
        LAS unsigned short* vt = (LAS unsigned short*)(Vt + (ch * 8) * VT_PITCH + key * 2);
        vt[0 * (VT_PITCH / 2)] = (unsigned short)(vv.x & 0xffffu); vt[1 * (VT_PITCH / 2)] = (unsigned short)(vv.x >> 16);
        vt[2 * (VT_PITCH / 2)] = (unsigned short)(vv.y & 0xffffu); vt[3 * (VT_PITCH / 2)] = (unsigned short)(vv.y >> 16);
        vt[4 * (VT_PITCH / 2)] = (unsigned short)(vv.z & 0xffffu); vt[5 * (VT_PITCH / 2)] = (unsigned short)(vv.z >> 16);
        vt[6 * (VT_PITCH / 2)] = (unsigned short)(vv.w & 0xffffu); vt[7 * (VT_PITCH / 2)] = (unsigned short)(vv.w >> 16);
    }
    for (int idx = tid; idx < 64 * 20; idx += 512) { const int d = idx / 20, k = 192 + idx % 20; *(LAS unsigned short*)(Vt + d * VT_PITCH + k * 2) = 0; }
    __syncthreads();
    const int ntask = sample ? 4 : 16, r16 = lane & 15, quad = lane >> 4;
    for (int task = wave; task < ntask; task += 8) {
        const int head = kvh * 4 + (task & 3), tql = 16 * (task >> 2);
        const int qrow = sample ? (8192 + 8 * blk + (r16 & 7)) : (64 * blk + tql + r16);
        bf16_t* qp = Qb + (size_t)qrow * 1024 + head * 64;
        const bf16x8 q0 = *(const bf16x8*)(qp + quad * 8), q1 = *(const bf16x8*)(qp + 32 + quad * 8);
        const float slope = exp2f(-0.5f * (float)(head + 1)), sink = P.in[9][head];
        float s[10][4]; float mx = -1e30f;
#pragma unroll
        for (int kb = 0; kb < 9; ++kb) {
            const LAS unsigned char* kp = Ks + (tql + kb * 16 + r16) * KS_PITCH + quad * 16;
            const bf16x8 a0 = *(const LAS bf16x8*)kp, a1 = *(const LAS bf16x8*)(kp + 64);
            f32x4 acc = {0.f, 0.f, 0.f, 0.f};
            acc = __builtin_amdgcn_mfma_f32_16x16x32_bf16(a0, q0, acc, 0, 0, 0);
            acc = __builtin_amdgcn_mfma_f32_16x16x32_bf16(a1, q1, acc, 0, 0, 0);
#pragma unroll
            for (int i = 0; i < 4; ++i) {
                const int kin = kb * 16 + quad * 4 + i, kl = tql + kin, dist = 128 + r16 - kin;
                const bool kvalid = sample ? (kl < 136) : (64 * blk - 112 + kl >= 0);
                const bool valid = dist >= 0 && dist <= 128 && kvalid;
                const float sv = valid ? acc[i] - slope * (float)dist : -1e30f;
                s[kb][i] = sv; mx = fmaxf(mx, sv);
            }
        }
        mx = fmaxf(mx, __shfl_xor(mx, 16)); mx = fmaxf(mx, __shfl_xor(mx, 32)); mx = fmaxf(mx, sink);
        float sum = 0.f;
#pragma unroll
        for (int kb = 0; kb < 9; ++kb)
#pragma unroll
            for (int i = 0; i < 4; ++i) { const float p = __expf(s[kb][i] - mx); s[kb][i] = p; sum += p; }
#pragma unroll
        for (int i = 0; i < 4; ++i) s[9][i] = 0.f;
        sum += __shfl_xor(sum, 16); sum += __shfl_xor(sum, 32);
        const float inv = 1.f / (sum + __expf(sink - mx));
        f32x4 o[4];
#pragma unroll
        for (int db = 0; db < 4; ++db) o[db] = (f32x4){0.f, 0.f, 0.f, 0.f};
#pragma unroll
        for (int pp = 0; pp < 5; ++pp) {
            u32x4 pw; pw.x = pk2(s[2 * pp][0], s[2 * pp][1]); pw.y = pk2(s[2 * pp][2], s[2 * pp][3]); pw.z = pk2(s[2 * pp + 1][0], s[2 * pp + 1][1]); pw.w = pk2(s[2 * pp + 1][2], s[2 * pp + 1][3]);
            const bf16x8 pb = __builtin_bit_cast(bf16x8, pw);
#pragma unroll
            for (int db = 0; db < 4; ++db) {
                const LAS unsigned char* vp = Vt + (db * 16 + r16) * VT_PITCH + (tql + pp * 32 + quad * 4) * 2;
                const u32x2 lo = *(const LAS u32x2*)vp, hi = *(const LAS u32x2*)(vp + 32);
                const u32x4 vw = {lo.x, lo.y, hi.x, hi.y};
                o[db] = __builtin_amdgcn_mfma_f32_16x16x32_bf16(__builtin_bit_cast(bf16x8, vw), pb, o[db], 0, 0, 0);
            }
        }
        if (!sample || r16 < 8) {
#pragma unroll
            for (int db = 0; db < 4; ++db) { const f32x4 v = o[db] * inv; *(u32x2*)(qp + db * 16 + quad * 4) = (u32x2){pk2(v[0], v[1]), pk2(v[2], v[3])}; }
        }
    }
    __syncthreads();
}

struct SsmCoef { float ar, ai; float br[16], bi[16]; };
__device__ __forceinline__ void ssm_load_coef(const Params& P, int g, int lane, SsmCoef& C) {
    const f32x2 ab = ((const f32x2*)(P.ws + WS_AB))[g * 64 + lane]; C.ar = ab[0]; C.ai = ab[1];
    const f32x2* bb = (const f32x2*)(P.ws + WS_BB) + (size_t)g * 16 * 64 + lane;
#pragma unroll
    for (int c = 0; c < 16; ++c) { const f32x2 b = bb[c * 64]; C.br[c] = b[0]; C.bi[c] = b[1]; }
}
__device__ __forceinline__ void ssm_load_u(const Params& P, int row0, int L, int g, LAS float* us, int lane) {
    const float* U = (const float*)(P.ws + WS_U);
    if (lane < L) { const f32x4* src = (const f32x4*)(U + (size_t)(row0 + lane) * 1024 + g * 16);
#pragma unroll
        for (int k = 0; k < 4; ++k) ((LAS f32x4*)(us + lane * 16))[k] = src[k]; }
    LDS_WAIT();
}
__device__ __forceinline__ void ssm_step(const SsmCoef& C, const LAS float* ut, float& hr, float& hi) {
    const f32x4 u0 = ((const LAS f32x4*)ut)[0], u1 = ((const LAS f32x4*)ut)[1], u2 = ((const LAS f32x4*)ut)[2], u3 = ((const LAS f32x4*)ut)[3];
    const float u[16] = {u0[0], u0[1], u0[2], u0[3], u1[0], u1[1], u1[2], u1[3], u2[0], u2[1], u2[2], u2[3], u3[0], u3[1], u3[2], u3[3]};
    float br = 0.f, bi = 0.f;
#pragma unroll
    for (int c = 0; c < 16; ++c) { br = fmaf(C.br[c], u[c], br); bi = fmaf(C.bi[c], u[c], bi); }
    const float nr = fmaf(C.ar, hr, fmaf(-C.ai, hi, br)), ni = fmaf(C.ar, hi, fmaf(C.ai, hr, bi));
    hr = nr; hi = ni;
}
__device__ __forceinline__ void ssm_passA(const Params& P, int item, LAS unsigned char* wl, int lane) {
    const int g = item & 63, c = item >> 6, row0 = c == 0 ? 9216 : 64 * (c - 1), L = c == 0 ? 16 : 64;
    LAS float* us = (LAS float*)wl;
    ssm_load_u(P, row0, L, g, us, lane);
    SsmCoef C; ssm_load_coef(P, g, lane, C);
    float hr = 0.f, hi = 0.f;
    for (int t = 0; t < L; ++t) ssm_step(C, us + t * 16, hr, hi);
    ((f32x2*)(P.ws + WS_E))[(size_t)item * 64 + lane] = (f32x2){hr, hi};
    LDS_WAIT();
}
constexpr int HS_PITCH = 272;
__device__ __forceinline__ void ssm_passB(const Params& P, int item, LAS unsigned char* wl, int lane) {
    const int g = item & 63; const bool sample = item >= 8192; const int c = sample ? 0 : 1 + (item >> 6), b = (item - 8192) >> 6;
    const int row0 = sample ? 8192 + 8 * b : 64 * (c - 1), L = sample ? 8 : 64;
    LAS float* us = (LAS float*)wl; LAS unsigned char* Hs = wl + 4096;
    ssm_load_u(P, row0, L, g, us, lane);
    SsmCoef C; ssm_load_coef(P, g, lane, C);
    float hr, hi;
    if (sample) { hr = P.in[4][(size_t)(b * 64 + g) * 64 + lane]; hi = P.in[5][(size_t)(b * 64 + g) * 64 + lane]; }
    else {
        float pr = C.ar, pi = C.ai;
#pragma unroll
        for (int k = 0; k < 6; ++k) { const float nr = pr * pr - pi * pi, ni = 2.f * pr * pi; pr = nr; pi = ni; }
        const f32x2* E = (const f32x2*)(P.ws + WS_E) + (size_t)g * 64 + lane;
        const f32x2 e0 = E[0]; hr = e0[0]; hi = e0[1];
        for (int cc = 1; cc < c; ++cc) { const f32x2 e = E[(size_t)cc * 4096]; const float nr = fmaf(pr, hr, fmaf(-pi, hi, e[0])), ni = fmaf(pr, hi, fmaf(pi, hr, e[1])); hr = nr; hi = ni; }
    }
    const int r16 = lane & 15, quad = lane >> 4;
    bf16x8 cf[4];
#pragma unroll
    for (int cc = 0; cc < 4; ++cc) {
        const float* src = (cc < 2 ? P.in[15] : P.in[16]) + (size_t)(g * 16 + r16) * 64 + (cc & 1) * 32 + quad * 8;
        f32x4 a = *(const f32x4*)src, bq = *(const f32x4*)(src + 4); if (cc >= 2) { a = -a; bq = -bq; }
        cf[cc] = __builtin_bit_cast(bf16x8, pk8(a, bq));
    }
    const f32x4 dd = *(const f32x4*)(P.in[17] + g * 16 + quad * 4);
    bf16_t* Z = (bf16_t*)(P.ws + WS_Z);
    for (int sub = 0; sub * 16 < L; ++sub) {
        const int nt = (L - sub * 16) < 16 ? (L - sub * 16) : 16;
        for (int t = 0; t < nt; ++t) {
            ssm_step(C, us + (sub * 16 + t) * 16, hr, hi);
            const unsigned w = pk2(hr, hi);
            *(LAS unsigned short*)(Hs + t * HS_PITCH + lane * 2) = (unsigned short)(w & 0xffffu);
            *(LAS unsigned short*)(Hs + t * HS_PITCH + 128 + lane * 2) = (unsigned short)(w >> 16);
        }
        LDS_WAIT();
        f32x4 acc = {0.f, 0.f, 0.f, 0.f};
#pragma unroll
        for (int cc = 0; cc < 4; ++cc) { const bf16x8 hb = *(const LAS bf16x8*)(Hs + r16 * HS_PITCH + cc * 64 + quad * 16); acc = __builtin_amdgcn_mfma_f32_16x16x32_bf16(cf[cc], hb, acc, 0, 0, 0); }
        const int tok = sub * 16 + r16;
        if (tok < L) {
            const f32x4 u4 = *(const LAS f32x4*)(us + tok * 16 + quad * 4); const f32x4 y = acc + dd * u4;
            *(u32x2*)(Z + (size_t)(row0 + tok) * 1024 + g * 16 + quad * 4) = (u32x2){pk2(gelu_tanh(y[0]), gelu_tanh(y[1])), pk2(gelu_tanh(y[2]), gelu_tanh(y[3]))};
        }
        LDS_WAIT();
    }
    if (sample) { P.out[O_SRS + (size_t)(b * 64 + g) * 64 + lane] = hr; P.out[O_SIS + (size_t)(b * 64 + g) * 64 + lane] = hi; }
    else if (c == 128) { P.out[O_SRP + g * 64 + lane] = hr; P.out[O_SIP + g * 64 + lane] = hi; }
}

__global__ void __launch_bounds__(512, 2) mega_fwd(Params P) {
    extern __shared__ __attribute__((aligned(16))) unsigned char lds_raw[];
    LAS unsigned char* lds = (LAS unsigned char*)lds_raw;
    cg::grid_group grid = cg::this_grid();
    const int tid = threadIdx.x, lane = tid & 63, wave = __builtin_amdgcn_readfirstlane(tid >> 6);
    const int G = gridDim.x, bx = blockIdx.x, gw = bx * 8 + wave, NGW = G * 8;
    unsigned char* ws = P.ws; float* out = P.out;
    bf16_t* Hb = (bf16_t*)(ws + WS_H);

    {
        LAS float* scr = (LAS float*)(lds + wave * 16384);
        constexpr int I_IN = 32 * 208, I_GLU = 16 * 32, I_A = 16 * 64, I_S = 16 * 64, I_OUT = 32 * 64, I_UP = 32 * 256, I_DN = 128 * 64;
        constexpr int NIT = I_IN + I_GLU + I_A + I_S + I_OUT + I_UP + I_DN;
        for (int it = gw; it < NIT; it += NGW) {
            int r = it;
            if (r < I_IN) { transpose_item(P.in[8], 2048, INC, (bf16_t*)(ws + WS_WIN), scr, r, lane); continue; } r -= I_IN;
            if (r < I_GLU) { transpose_item(P.in[18], 1024, 1024, (bf16_t*)(ws + WS_WGLU), scr, r, lane); continue; } r -= I_GLU;
            if (r < I_A) { transpose_item(P.in[20], 1024, 2048, (bf16_t*)(ws + WS_WA), scr, r, lane); continue; } r -= I_A;
            if (r < I_S) { transpose_item(P.in[21], 1024, 2048, (bf16_t*)(ws + WS_WS), scr, r, lane); continue; } r -= I_S;
            if (r < I_OUT) { transpose_item(P.in[22], 2048, 2048, (bf16_t*)(ws + WS_WOUT), scr, r, lane); continue; } r -= I_OUT;
            if (r < I_UP) { transpose_item(P.in[24], 2048, DFF, (bf16_t*)(ws + WS_WUP), scr, r, lane); continue; } r -= I_UP;
            transpose_item(P.in[25], DFF, 2048, (bf16_t*)(ws + WS_WDN), scr, r, lane);
        }
        for (int m = gw; m < MP; m += NGW) {
            if (m < M1) { const float* x = m < 8192 ? P.in[0] + (size_t)m * 2048 : (m < 9216 ? P.in[1] + (size_t)(m - 8192) * 2048 : P.in[6] + (size_t)(m - 9216) * 2048);
                rms_row(x, P.in[7], Hb + (size_t)m * 2048, nullptr, lane); }
            else { for (int j = 0; j < 4; ++j) ((u32x4*)(Hb + (size_t)m * 2048))[64 * j + lane] = (u32x4){0u, 0u, 0u, 0u}; }
        }
        const int gt = bx * 512 + tid, NGT = G * 512;
        if (gt < 4096) {
            const int g = gt >> 6, p = gt & 63;
            const float are = P.in[10][gt], aim = P.in[11][gt], dt = expf(P.in[12][g]);
            const float mag = expf(dt * are), abr = mag * cosf(dt * aim), abi = mag * sinf(dt * aim);
            const float nr = abr - 1.f, ni = abi, den = are * are + aim * aim, fr = (nr * are + ni * aim) / den, fi = (ni * are - nr * aim) / den;
            ((f32x2*)(ws + WS_AB))[gt] = (f32x2){abr, abi};
            for (int c = 0; c < 16; ++c) { const float br = P.in[13][(size_t)gt * 16 + c], bi = P.in[14][(size_t)gt * 16 + c];
                ((f32x2*)(ws + WS_BB))[(size_t)(g * 16 + c) * 64 + p] = (f32x2){fr * br - fi * bi, fr * bi + fi * br}; }
        }
        for (int i = gt; i < 2 * 128 * 120 * 64; i += NGT) {
            const int which = i / (128 * 120 * 64), r = i % (128 * 120 * 64), bw = r >> 6, c4 = r & 63, b = bw / 120, w = bw % 120;
            const f32x4 v = *(const f32x4*)(P.in[2 + which] + ((size_t)(b * 128 + w + 8)) * 256 + c4 * 4);
            *(f32x4*)(out + (which ? O_VS : O_KS) + ((size_t)(b * 128 + w)) * 256 + c4 * 4) = v;
        }
    }
    grid.sync();
    {
        pg8::Gemm g{Hb, (const bf16_t*)(ws + WS_WIN), MP, INC, 2048}; pg8::StaticOrder S; S.init(MP, INC, G, bx);
        Epi<F1> E{F1{(bf16_t*)(ws + WS_Q), (bf16_t*)(ws + WS_K), (bf16_t*)(ws + WS_V), (bf16_t*)(ws + WS_G), (float*)(ws + WS_U), out}};
        pg8::gemm_phase<Epi<F1>, pg8::StaticOrder, true, true>(lds, g, S, E);
    }
    grid.sync();
    {
        for (int u = bx; u < 1024; u += G) attn_unit(P, u, lds, tid, wave, lane);
        LAS unsigned char* wl = lds + wave * 8448;
        for (int it = gw; it < 129 * 64; it += NGW) ssm_passA(P, it, wl, lane);
    }
    grid.sync();
    {
        LAS unsigned char* wl = lds + wave * 8448;
        for (int it = gw; it < 16384; it += NGW) ssm_passB(P, it, wl, lane);
    }
    grid.sync();
    {
        pg8::Gemm g{(const bf16_t*)(ws + WS_Z), (const bf16_t*)(ws + WS_WGLU), M2, 1024, 1024}; pg8::StaticOrder S; S.init(M2, 1024, G, bx);
        Epi<F4> E{F4{(const bf16_t*)(ws + WS_Z), P.in[19], (bf16_t*)(ws + WS_U)}};
        pg8::gemm_phase<Epi<F4>, pg8::StaticOrder, true, true>(lds, g, S, E);
    }
    grid.sync();
    {
        pg8::StaticOrder S; S.init(M2, 2048, G, bx);
        { pg8::Gemm g{(const bf16_t*)(ws + WS_Q), (const bf16_t*)(ws + WS_WA), M2, 2048, 1024};
          Epi<F5a> E{F5a{(const bf16_t*)(ws + WS_G), out + O_Y}};
          pg8::gemm_phase<Epi<F5a>, pg8::StaticOrder, true, true>(lds, g, S, E); }
        { pg8::Gemm g{(const bf16_t*)(ws + WS_U), (const bf16_t*)(ws + WS_WS), M2, 2048, 1024};
          Epi<F5b> E{F5b{(const bf16_t*)(ws + WS_G), out + O_Y, Hb}};
          pg8::gemm_phase<Epi<F5b>, pg8::StaticOrder, true, true>(lds, g, S, E); }
    }
    grid.sync();
    {
        pg8::Gemm g{Hb, (const bf16_t*)(ws + WS_WOUT), M2, 2048, 2048}; pg8::StaticOrder S; S.init(M2, 2048, G, bx);
        Epi<F6> E{F6{P.in[0], P.in[1], out + O_Y}};
        pg8::gemm_phase<Epi<F6>, pg8::StaticOrder, true, true>(lds, g, S, E);
    }
    grid.sync();
    for (int m = gw; m < M2; m += NGW) rms_row(out + O_Y + (size_t)m * 2048, P.in[23], Hb + (size_t)m * 2048, nullptr, lane);
    grid.sync();
    {
        pg8::Gemm g{Hb, (const bf16_t*)(ws + WS_WUP), M2, DFF, 2048}; pg8::StaticOrder S; S.init(M2, DFF, G, bx);
        Epi<F8> E{F8{(bf16_t*)(ws + WS_ACT)}};
        pg8::gemm_phase<Epi<F8>, pg8::StaticOrder, true, true>(lds, g, S, E);
    }
    grid.sync();
    {
        pg8::Gemm g{(const bf16_t*)(ws + WS_ACT), (const bf16_t*)(ws + WS_WDN), M2, 2048, DFF}; pg8::StaticOrder S; S.init(M2, 2048, G, bx);
        Epi<F9> E{F9{out + O_Y}};
        pg8::gemm_phase<Epi<F9>, pg8::StaticOrder, true, true>(lds, g, S, E);
    }
    grid.sync();
    for (int m = gw; m < M2; m += NGW) rms_row(out + O_Y + (size_t)m * 2048, P.in[26], nullptr, out + O_Y + (size_t)m * 2048, lane);
}

extern "C" void kernel_launch(void* const* d_in, const int* in_sizes, int n_in, void* d_out, int out_size, void* d_ws, size_t ws_size, hipStream_t stream) {
    static int grid = 0;
    if (grid == 0) {
        if (n_in != 27 || out_size != 28385280 || ws_size < WS_END) { fprintf(stderr, "kernel_launch: unexpected shapes (n_in %d, out %d, ws %zu < %zu)\n", n_in, out_size, ws_size, (size_t)WS_END); grid = -1; return; }
        int dev = 0, cus = 0, per_cu = 0;
        hipGetDevice(&dev); hipDeviceGetAttribute(&cus, hipDeviceAttributeMultiprocessorCount, dev);
        if (hipFuncSetAttribute((const void*)mega_fwd, hipFuncAttributeMaxDynamicSharedMemorySize, LDS_BYTES) != hipSuccess) { fprintf(stderr, "kernel_launch: hipFuncSetAttribute failed\n"); grid = -1; return; }
        if (hipOccupancyMaxActiveBlocksPerMultiprocessor(&per_cu, (const void*)mega_fwd, 512, LDS_BYTES) != hipSuccess || per_cu < 1) { fprintf(stderr, "kernel_launch: occupancy query says %d\n", per_cu); (void)hipGetLastError(); per_cu = 1; }
        grid = cus * per_cu;
    }
    if (grid < 0) return;
    Params p{};
    for (int i = 0; i < 27; ++i) p.in[i] = (const float*)d_in[i];
    p.out = (float*)d_out; p.ws = (unsigned char*)d_ws;
    void* args[] = {&p};
    hipError_t e = hipLaunchCooperativeKernel((const void*)mega_fwd, dim3(grid), dim3(512), args, LDS_BYTES, stream);
    if (e != hipSuccess) fprintf(stderr, "cooperative launch failed: %s (grid %d)\n", hipGetErrorString(e), grid);
}
```

```cpp
#include <hip/hip_runtime.h>
#include <hip/hip_cooperative_groups.h>
#include <cstdio>
#include <cstdint>
namespace cg = cooperative_groups;
namespace pg8 {
#define PG8_LAS __attribute__((address_space(3)))
typedef unsigned short bf16_t;
typedef short bf16x8 __attribute__((ext_vector_type(8)));
typedef float f32x4 __attribute__((ext_vector_type(4)));
typedef unsigned u32x4 __attribute__((ext_vector_type(4)));
constexpr int BM = 256, BK = 64, HALF = 128, HTB = HALF * BK * 2  , STAGE_BYTES = 8 * HTB, NXCD = 8, WGM = 8;

__host__ __device__ __forceinline__ int lds_byte(int r, int c) { const int st = (r >> 4) * 2 + (c >> 5), rr = r & 15, cc = c & 31, ob = rr * 64 + cc * 2; return st * 1024 + (ob ^ (((ob >> 9) & 1) << 5)); }
__host__ __device__ __forceinline__ void stage_rc(int b, int& R, int& C) { const int st = b / 1024, sb = b % 1024, swz = sb ^ (((sb >> 9) & 1) << 5); R = (st >> 1) * 16 + swz / 64; C = (st & 1) * 32 + (swz % 64) / 2; }
__host__ __device__ __forceinline__ int perm32(int rho) { const int n = rho >> 4, i = rho & 15; return 8 * (i >> 2) + 4 * n + (i & 3); }

struct Unit { int pm, pn, pk, nt, koff, kind; };
struct Gemm { const bf16_t* A; const bf16_t* Bt; int M, N, K; const bf16_t* A2; const bf16_t* Bt2; };

struct StaticOrder {
    int nM, nN, nwg, G, c, nt;
    __host__ __device__ void init(int M, int N, int G_, int c_, int nt_) { nM = M / BM; nN = N / BM; nwg = nM * nN; G = G_; c = c_; nt = nt_; }
    __host__ __device__ bool next(int i, Unit& u) const {
        const long L = (long)i * G + c; if (L >= nwg) return false;
        int wgid = (int)L; { const int q = nwg / NXCD, r = nwg % NXCD, xcd = wgid % NXCD, off = wgid / NXCD; wgid = (xcd < r ? xcd * (q + 1) : r * (q + 1) + (xcd - r) * q) + off; }
        const int nig = WGM * nN, gid = wgid / nig, fm = gid * WGM, gsz = (nM - fm) < WGM ? (nM - fm) : WGM;
        u.pm = fm + ((wgid % nig) % gsz); u.pn = (wgid % nig) / gsz; u.pk = 0; u.nt = nt; u.koff = 0; u.kind = 0; return true;
    }
    __device__ __forceinline__ void a_ready(const Unit&) const {}
    __device__ __forceinline__ void done(const Unit&) const {}
};
template <class Epi, class Sched, bool ALIGN_EPI = false, bool SP2 = false>
__device__ __forceinline__ void gemm_phase(PG8_LAS unsigned char* lds, const Gemm g, const Sched& S, const Epi& E) {
    const int tid = threadIdx.x, wid = __builtin_amdgcn_readfirstlane(tid >> 6), lane = tid & 63, wr = wid >> 2, wc = wid & 3, fr = lane & 15, fq = lane >> 4;
    const int K = g.K;
    unsigned voffA[2], voffB[2];
#pragma unroll
    for (int i = 0; i < 2; ++i) { int R, C; stage_rc(tid * 16 + i * 8192, R, C); const int Rb = Epi::PERM ? ((R & ~31) + perm32(R & 31)) : R;
        voffA[i] = (unsigned)(R * K + C) * 2u; voffB[i] = (unsigned)(Rb * K + C) * 2u; }
    const size_t kstep = (size_t)(BK * 2);
    const size_t hstep = (size_t)HALF * K * 2;
    const size_t tstep = 2 * hstep;
    const unsigned ldsw = (unsigned)wid * 1024u;
    const int aoff = lds_byte(wr * 64 + fr, fq * 8), boff = lds_byte(wc * 32 + fr, fq * 8);
#define PG8_SA(b, h) (((b) * 2 + (h)) * HTB)
#define PG8_SB(b, h) ((4 + (b) * 2 + (h)) * HTB)
#define PG8_STAGE(bufoff, gbase, voff) do { _Pragma("unroll") for (int _i = 0; _i < 2; ++_i) \
        __builtin_amdgcn_global_load_lds((const unsigned*)((const char*)(gbase) + (voff)[_i]), (PG8_LAS unsigned*)(lds + (bufoff) + ldsw + _i * 8192), 16, 0, 0); } while (0)
#define PG8_LDA(dst, b, h) do { _Pragma("unroll") for (int m = 0; m < 4; ++m) _Pragma("unroll") for (int k = 0; k < 2; ++k) dst[m][k] = *(const PG8_LAS bf16x8*)(lds + PG8_SA(b, h) + aoff + m * 2048 + k * 1024); } while (0)
#define PG8_LDB(dst, b, h) do { _Pragma("unroll") for (int n = 0; n < 2; ++n) _Pragma("unroll") for (int k = 0; k < 2; ++k) dst[n][k] = *(const PG8_LAS bf16x8*)(lds + PG8_SB(b, h) + boff + n * 2048 + k * 1024); } while (0)
#define PG8_MMA(ai, bj, At, Bt) do { __builtin_amdgcn_s_setprio(1); _Pragma("unroll") for (int m = 0; m < 4; ++m) _Pragma("unroll") for (int n = 0; n < 2; ++n) _Pragma("unroll") for (int k = 0; k < 2; ++k) \
        acc[ai][bj][m][n] = __builtin_amdgcn_mfma_f32_16x16x32_bf16(Bt[n][k], At[m][k], acc[ai][bj][m][n], 0, 0, 0); __builtin_amdgcn_s_setprio(0); } while (0)
#define PG8_WAIT_V(n) asm volatile("s_waitcnt vmcnt(" #n ")" ::: "memory")
#define PG8_WAIT_L(n) asm volatile("s_waitcnt lgkmcnt(" #n ")" ::: "memory")
#define PG8_BAR __builtin_amdgcn_s_barrier()
#define PG8_SCHED __builtin_amdgcn_sched_barrier(0)
    Unit cur, nxt; int ui = 0;
    if (!S.next(0, cur)) return;
    int nt = cur.nt;
    f32x4 acc[2][2][4][2];
#pragma unroll
    for (int a = 0; a < 2; ++a)
#pragma unroll
        for (int b = 0; b < 2; ++b)
#pragma unroll
            for (int m = 0; m < 4; ++m)
#pragma unroll
                for (int n = 0; n < 2; ++n) acc[a][b][m][n] = (f32x4){0.f, 0.f, 0.f, 0.f};
    bf16x8 At[4][2], B0[2][2], B1[2][2];
    const char* cA = (const char*)(cur.kind ? g.A2 : g.A) + (size_t)cur.pm * tstep + (size_t)cur.koff * kstep; const char* cB = (const char*)(cur.kind ? g.Bt2 : g.Bt) + (size_t)cur.pn * tstep + (size_t)cur.koff * kstep;
    S.a_ready(cur);
    if constexpr (SP2) {
        PG8_STAGE(PG8_SB(0, 0), cB, voffB); PG8_STAGE(PG8_SB(0, 1), cB + hstep, voffB); PG8_STAGE(PG8_SA(0, 0), cA, voffA); PG8_STAGE(PG8_SA(0, 1), cA + hstep, voffA);
        if (wr == 1) PG8_BAR;
        PG8_WAIT_V(2); PG8_BAR;
        PG8_STAGE(PG8_SB(1, 0), cB + kstep, voffB); PG8_STAGE(PG8_SA(1, 0), cA + kstep, voffA); PG8_STAGE(PG8_SB(1, 1), cB + hstep + kstep, voffB);
        PG8_WAIT_V(6); PG8_BAR;
    } else {
        PG8_STAGE(PG8_SB(0, 0), cB, voffB); PG8_STAGE(PG8_SA(0, 0), cA, voffA); PG8_STAGE(PG8_SB(0, 1), cB + hstep, voffB); PG8_STAGE(PG8_SA(0, 1), cA + hstep, voffA);
        if (wr == 1) PG8_BAR;
        PG8_WAIT_V(4); PG8_BAR;
        PG8_STAGE(PG8_SB(1, 0), cB + kstep, voffB); PG8_STAGE(PG8_SA(1, 0), cA + kstep, voffA); PG8_STAGE(PG8_SB(1, 1), cB + hstep + kstep, voffB);
        PG8_WAIT_V(6); PG8_BAR;
    }
    for (;;) {
        const bool has_next = S.next(ui + 1, nxt);
        const char* nA = has_next ? (const char*)(nxt.kind ? g.A2 : g.A) + (size_t)nxt.pm * tstep + (size_t)nxt.koff * kstep : cA; const char* nB = has_next ? (const char*)(nxt.kind ? g.Bt2 : g.Bt) + (size_t)nxt.pn * tstep + (size_t)nxt.koff * kstep : cB;
        for (int t = 0; t < nt; t += 2) {
            const bool last = (t == nt - 2);
            const char* a1 = cA + (size_t)(t + 1) * kstep;
            const char* a2 = last ? nA : cA + (size_t)(t + 2) * kstep; const char* b2 = last ? nB : cB + (size_t)(t + 2) * kstep;
            const char* a3 = a2 + kstep; const char* b3 = b2 + kstep;
            if (last && has_next) S.a_ready(nxt);
            if constexpr (SP2) {
            PG8_LDB(B0, 0, 0); PG8_LDB(B1, 0, 1); PG8_SCHED; PG8_LDA(At, 0, 0); PG8_STAGE(PG8_SA(1, 1), a1 + hstep, voffA);
            PG8_WAIT_V(8); PG8_WAIT_L(0); PG8_BAR; PG8_MMA(0, 0, At, B0); PG8_MMA(0, 1, At, B1); PG8_BAR; PG8_SCHED;
            PG8_LDA(At, 0, 1); PG8_STAGE(PG8_SB(0, 0), b2, voffB); PG8_STAGE(PG8_SB(0, 1), b2 + hstep, voffB); PG8_STAGE(PG8_SA(0, 0), a2, voffA);
            PG8_WAIT_V(8); PG8_WAIT_L(0); PG8_BAR; PG8_MMA(1, 0, At, B0); PG8_MMA(1, 1, At, B1); PG8_BAR; PG8_SCHED;
            PG8_LDB(B0, 1, 0); PG8_LDB(B1, 1, 1); PG8_SCHED; PG8_LDA(At, 1, 0); PG8_STAGE(PG8_SA(0, 1), a2 + hstep, voffA);
            PG8_WAIT_V(8); PG8_WAIT_L(0); PG8_BAR; PG8_MMA(0, 0, At, B0); PG8_MMA(0, 1, At, B1); PG8_BAR; PG8_SCHED;
            PG8_LDA(At, 1, 1); PG8_STAGE(PG8_SB(1, 0), b3, voffB); PG8_STAGE(PG8_SB(1, 1), b3 + hstep, voffB); PG8_STAGE(PG8_SA(1, 0), a3, voffA);
            PG8_WAIT_V(8); PG8_WAIT_L(0); PG8_BAR; PG8_MMA(1, 0, At, B0); PG8_MMA(1, 1, At, B1); PG8_BAR; PG8_SCHED;
            } else {
            PG8_LDB(B0, 0, 0); PG8_SCHED; PG8_LDA(At, 0, 0); PG8_STAGE(PG8_SA(1, 1), a1 + hstep, voffA);
            PG8_WAIT_L(8); PG8_BAR; PG8_WAIT_L(0); PG8_MMA(0, 0, At, B0); PG8_BAR; PG8_SCHED;
            PG8_LDB(B1, 0, 1); PG8_STAGE(PG8_SB(0, 0), b2, voffB);
            PG8_BAR; PG8_WAIT_L(0); PG8_MMA(0, 1, At, B1); PG8_BAR;
            PG8_LDA(At, 0, 1); PG8_STAGE(PG8_SA(0, 0), a2, voffA);
            PG8_BAR; PG8_WAIT_L(0); PG8_MMA(1, 0, At, B0); PG8_BAR; PG8_SCHED;
            PG8_STAGE(PG8_SB(0, 1), b2 + hstep, voffB);
            PG8_WAIT_V(6); PG8_BAR; PG8_MMA(1, 1, At, B1); PG8_BAR;
            PG8_LDB(B0, 1, 0); PG8_SCHED; PG8_LDA(At, 1, 0); PG8_STAGE(PG8_SA(0, 1), a2 + hstep, voffA);
            PG8_WAIT_L(8); PG8_BAR; PG8_WAIT_L(0); PG8_MMA(0, 0, At, B0); PG8_BAR; PG8_SCHED;
            PG8_LDB(B1, 1, 1); PG8_STAGE(PG8_SB(1, 0), b3, voffB);
            PG8_BAR; PG8_WAIT_L(0); PG8_MMA(0, 1, At, B1); PG8_BAR;
            PG8_LDA(At, 1, 1); PG8_STAGE(PG8_SA(1, 0), a3, voffA);
            PG8_BAR; PG8_WAIT_L(0); PG8_MMA(1, 0, At, B0); PG8_BAR; PG8_SCHED;
            PG8_STAGE(PG8_SB(1, 1), b3 + hstep, voffB);
            PG8_WAIT_V(6); PG8_BAR; PG8_MMA(1, 1, At, B1); PG8_BAR;
            }
        }
        if constexpr (ALIGN_EPI) { if (wr == 0) PG8_BAR; }
        bool keep = false;
        if constexpr (!Epi::AFTER_DRAIN) { keep = E(acc, cur, wr, wc, fr, fq); S.done(cur); }
        if (!has_next) break;
        if (!keep)
        {
#pragma unroll
        for (int a = 0; a < 2; ++a)
#pragma unroll
            for (int b = 0; b < 2; ++b)
#pragma unroll
                for (int m = 0; m < 4; ++m)
#pragma unroll
                    for (int n = 0; n < 2; ++n) acc[a][b][m][n] = (f32x4){0.f, 0.f, 0.f, 0.f};
        }
        cur = nxt; cA = nA; cB = nB; ++ui; nt = cur.nt;
        if constexpr (ALIGN_EPI) { if (wr == 1) PG8_BAR; }
    }
    PG8_WAIT_V(0);
    if constexpr (!ALIGN_EPI) { if (wr == 0) PG8_BAR; }
    PG8_BAR;
    if constexpr (Epi::AFTER_DRAIN) { E.fused(acc, cur, wr, wc, fr, fq, lds, wid, lane); S.done(cur); }
#undef PG8_SA
#undef PG8_SB
#undef PG8_STAGE
#undef PG8_LDA
#undef PG8_LDB
#undef PG8_MMA
#undef PG8_WAIT_V
#undef PG8_WAIT_L
#undef PG8_BAR
#undef PG8_SCHED
}
}

using pg8::bf16_t; using pg8::bf16x8; using pg8::f32x4; using pg8::u32x4;
#define LAS __attribute__((address_space(3)))
typedef float f32x2 __attribute__((ext_vector_type(2)));
typedef unsigned u32x2 __attribute__((ext_vector_type(2)));
typedef __bf16 bf16x2_t __attribute__((ext_vector_type(2)));

constexpr int DM = 2048, AW = 1024, KVW = 256, INC = 6656, DFF = 8192;
constexpr int M2 = 9216, M1 = 9232, MP = 9472;
constexpr int PAST = 16384;
constexpr size_t O_Y = 0, O_KP = 18874368, O_VP = 18907136, O_SRP = 18939904, O_SIP = 18944000, O_KS = 18948096, O_VS = 23142400, O_SRS = 27336704, O_SIS = 27860992;
constexpr size_t WS_AB = 0;
constexpr size_t WS_BB = 32768;
constexpr size_t WS_E = WS_BB + 524288;
constexpr size_t WS_BAR = 8388608 - 65536;
constexpr size_t WS_WIN = 8388608;
constexpr size_t WS_WGLU = WS_WIN + (size_t)INC * DM * 2;
constexpr size_t WS_WA = WS_WGLU + (size_t)1024 * 1024 * 2;
constexpr size_t WS_WS = WS_WA + (size_t)2048 * 1024 * 2;
constexpr size_t WS_WOUT = WS_WS + (size_t)2048 * 1024 * 2;
constexpr size_t WS_WUP = WS_WOUT + (size_t)2048 * 2048 * 2;
constexpr size_t WS_WDN = WS_WUP + (size_t)DFF * DM * 2;
constexpr size_t WS_H = WS_WDN + (size_t)DFF * DM * 2;
constexpr size_t WS_R = WS_H + (size_t)MP * DM * 2;
constexpr size_t WS_Q = WS_R;
constexpr size_t WS_K = WS_Q + (size_t)MP * 1024 * 2;
constexpr size_t WS_V = WS_K + (size_t)MP * 256 * 2;
constexpr size_t WS_U = WS_V + (size_t)MP * 256 * 2;
constexpr size_t WS_G = WS_U + (size_t)MP * 1024 * 4;
constexpr size_t WS_Z = WS_G + (size_t)MP * 4096 * 2;
constexpr size_t WS_END = WS_Z + (size_t)MP * 1024 * 2;
constexpr size_t WS_ACT = WS_R;
static_assert(WS_ACT + (size_t)M2 * DFF * 2 <= WS_END, "act overlay");
static_assert(WS_E + (size_t)129 * 4096 * 8 <= WS_BAR, "ssm scratch");

#ifndef GS_AT_START
#define GS_AT_START 1
#endif
constexpr int UP_P0 = 1536, UP_P5 = 1536, DN_P5 = 1536;
constexpr int DN_P0 = 0;
#ifndef EPI_SB
#define EPI_SB 0
#endif
#ifndef PROBE
#define PROBE 0
#endif
constexpr int LDS_BYTES = 135168;

struct Params { const float* in[27]; float* out; unsigned char* ws; };

__device__ __forceinline__ unsigned pk2(float lo, float hi) { f32x2 v = {lo, hi}; bf16x2_t b = __builtin_convertvector(v, bf16x2_t); return __builtin_bit_cast(unsigned, b); }
__device__ __forceinline__ u32x4 pk8(f32x4 a, f32x4 b) { u32x4 w; w.x = pk2(a[0], a[1]); w.y = pk2(a[2], a[3]); w.z = pk2(b[0], b[1]); w.w = pk2(b[2], b[3]); return w; }
__device__ __forceinline__ float bf_lo(unsigned w) { return __builtin_bit_cast(float, w << 16); }
__device__ __forceinline__ float bf_hi(unsigned w) { return __builtin_bit_cast(float, w & 0xffff0000u); }
__device__ __forceinline__ void unpk8(u32x4 w, f32x4& a, f32x4& b) { a = (f32x4){bf_lo(w.x), bf_hi(w.x), bf_lo(w.y), bf_hi(w.y)}; b = (f32x4){bf_lo(w.z), bf_hi(w.z), bf_lo(w.w), bf_hi(w.w)}; }
__device__ __forceinline__ float sigmoidf_(float x) { return __builtin_amdgcn_rcpf(1.f + __expf(-x)); }
__device__ __forceinline__ f32x4 sig4(f32x4 v) { return (f32x4){sigmoidf_(v[0]), sigmoidf_(v[1]), sigmoidf_(v[2]), sigmoidf_(v[3])}; }
__device__ __forceinline__ float gelu_tanh(float x) { const float t = 1.5957691216057308f * (x + 0.044715f * x * x * x); return x * sigmoidf_(t); }
__device__ __forceinline__ float wave_sum(float v) {
#pragma unroll
    for (int o = 1; o < 64; o <<= 1) v += __shfl_xor(v, o);
    return v;
}
#define LDS_WAIT() asm volatile("s_waitcnt lgkmcnt(0)" ::: "memory")

struct SchedRem {
    int pm0, nN, sp, nt, G, c;
    __device__ __forceinline__ bool next(int i, pg8::Unit& u) const { const int L = i * G + c; if (L >= 4 * nN * sp) return false; u.pk = L % sp; const int rt = L / sp; u.pm = pm0 + (rt & 3); u.pn = rt >> 2; u.nt = nt; u.koff = u.pk * nt; u.kind = 0; return true; }
};
struct SchedSplit {
    pg8::StaticOrder full; SchedRem rem;
    __device__ __forceinline__ bool next(int i, pg8::Unit& u) const {
        const int tot = 4 * rem.nN * rem.sp, nr = rem.c < tot ? (tot - rem.c + rem.G - 1) / rem.G : 0, nf = full.c < full.nwg ? (full.nwg - full.c + full.G - 1) / full.G : 0;
        if ((rem.c >> 3) & 1) return i < nf ? full.next(i, u) : rem.next(i - nf, u);
        return i < nr ? rem.next(i, u) : full.next(i - nr, u); }
    __device__ __forceinline__ void a_ready(const pg8::Unit&) const {}
    __device__ __forceinline__ void done(const pg8::Unit&) const {}
};
struct SchedP4 {
    int G, c;
    __device__ __forceinline__ bool next(int i, pg8::Unit& u) const {
        const int L = i * G + c; if (L >= 256) return false;
        pg8::StaticOrder so;
        if (L < 144) { so.init(M2, 1024, 1 << 28, L, 16); so.next(0, u); }
        else { so.init(14 * 256, 2048, 1 << 28, L - 144, 16); so.next(0, u); u.pm += 22; u.kind = 1; }
        return true;
    }
    __device__ __forceinline__ void a_ready(const pg8::Unit&) const {}
    __device__ __forceinline__ void done(const pg8::Unit&) const {}
};
struct SchedP5 {
    int G, c;
    __device__ __forceinline__ bool next(int i, pg8::Unit& u) const {
        const bool g256 = (G == 256); int cnt = 0;
        const int stride = g256 ? 80 : G, last = g256 ? (c < 176 ? c + 1 : 288) : 288;
        for (int it = c; it < last; it += stride) {
            const int n = it < 176 ? 2 : 1;
            if (i < cnt + n) {
                pg8::StaticOrder so;
                if (it < 176) { so.init(22 * 256, 2048, 1 << 28, it, 16); so.next(0, u); u.kind = i - cnt; }
                else { so.init(14 * 256, 2048, 1 << 28, it - 176, 16); so.next(0, u); u.pm += 22; u.kind = 2; }
                return true;
            }
            cnt += n;
        }
        return false;
    }
    __device__ __forceinline__ void a_ready(const pg8::Unit&) const {}
    __device__ __forceinline__ void done(const pg8::Unit&) const {}
};
struct NoPre {};
template <class F> struct Epi {
    static constexpr bool PERM = true, AFTER_DRAIN = false;
    F f;
    __device__ __forceinline__ bool operator()(f32x4 (&acc)[2][2][4][2], const pg8::Unit& u, int wr, int wc, int fr, int fq) const {
        const int row0 = u.pm * 256 + wr * 64 + fr, col0 = u.pn * 256 + wc * 32 + 8 * fq, kk = u.pk + 16 * u.kind;
#pragma unroll
        for (int ai = 0; ai < 2; ++ai)
#pragma unroll
            for (int mp = 0; mp < 4; mp += 2) {
                typename F::Pre p[2][2];
#pragma unroll
                for (int mi = 0; mi < 2; ++mi)
#pragma unroll
                    for (int bj = 0; bj < 2; ++bj) f.pre(row0 + ai * 128 + (mp + mi) * 16, col0 + bj * 128, kk, p[mi][bj]);
#pragma unroll
                for (int mi = 0; mi < 2; ++mi)
#pragma unroll
                    for (int bj = 0; bj < 2; ++bj) f.post(row0 + ai * 128 + (mp + mi) * 16, col0 + bj * 128, acc[ai][bj][mp + mi][0], acc[ai][bj][mp + mi][1], kk, p[mi][bj]);
            }
        return false;
    }
};
struct F1 {
    typedef NoPre Pre;
    bf16_t *Q, *Kb, *Vb, *G; float* U; float* out;
    __device__ __forceinline__ void pre(int, int, int, Pre&) const {}
    __device__ __forceinline__ void post(int row, int col, f32x4 v0, f32x4 v1, int, const Pre&) const {
        if (col < 1024) { *(u32x4*)(Q + (size_t)row * 1024 + col) = pk8(v0 * 0.125f, v1 * 0.125f); }
        else if (col < 1536) {
            const bool isv = col >= 1280; const int c = col - (isv ? 1280 : 1024);
            *(u32x4*)((isv ? Vb : Kb) + (size_t)row * 256 + c) = pk8(v0, v1);
            float* o = nullptr;
            if (row >= 8064 && row < 8192) o = out + (isv ? O_VP : O_KP) + (size_t)(row - 8064) * 256 + c;
            else if (row >= 8192 && row < 9216) { const int b = (row - 8192) >> 3, i = (row - 8192) & 7; o = out + (isv ? O_VS : O_KS) + (size_t)(b * 128 + 120 + i) * 256 + c; }
            if (o) { *(f32x4*)o = v0; *(f32x4*)(o + 4) = v1; }
        } else if (col < 2560) { float* o = U + (size_t)row * 1024 + (col - 1536); *(f32x4*)o = v0; *(f32x4*)(o + 4) = v1; }
        else { *(u32x4*)(G + (size_t)row * 4096 + (col - 2560)) = pk8(sig4(v0), sig4(v1)); }
    }
};
struct F45 {
    struct Pre { u32x4 w; f32x4 b0, b1; };
    const bf16_t* Z; const float* bias; bf16_t* S; const bf16_t* G; float* T;
    __device__ __forceinline__ void pre(int row, int col, int kk, Pre& p) const {
        if (kk == 0) { p.w = *(const u32x4*)(Z + (size_t)row * 1024 + col); p.b0 = *(const f32x4*)(bias + col); p.b1 = *(const f32x4*)(bias + col + 4); }
        else p.w = *(const u32x4*)(G + (size_t)row * 4096 + col);
    }
    __device__ __forceinline__ void post(int row, int col, f32x4 v0, f32x4 v1, int kk, const Pre& p) const {
        f32x4 a, b; unpk8(p.w, a, b);
        if (kk == 0) *(u32x4*)(S + (size_t)row * 1024 + col) = pk8(a * sig4(v0 + p.b0), b * sig4(v1 + p.b1));
        else { float* o = T + (size_t)row * 2048 + col; *(f32x4*)o = a * v0; *(f32x4*)(o + 4) = b * v1; }
    }
};
struct EpiP5 {
    static constexpr bool PERM = true, AFTER_DRAIN = false;
    const bf16_t* G; const float* T; bf16_t* Mg;
    __device__ __forceinline__ bool operator()(f32x4 (&acc)[2][2][4][2], const pg8::Unit& u, int wr, int wc, int fr, int fq) const {
        const int row0 = u.pm * 256 + wr * 64 + fr, col0 = u.pn * 256 + wc * 32 + 8 * fq;
        const f32x4 tiny = {1e-20f, 1e-20f, 1e-20f, 1e-20f};
#pragma unroll
        for (int ai = 0; ai < 2; ++ai)
#pragma unroll
            for (int mp = 0; mp < 4; ++mp) {
                u32x4 gs[1][2], ga[1][2]; f32x4 t0[1][2], t1[1][2];
#pragma unroll
                for (int mi = 0; mi < 1; ++mi)
#pragma unroll
                    for (int bj = 0; bj < 2; ++bj) {
                        const int row = row0 + ai * 128 + (mp + mi) * 16, col = col0 + bj * 128;
                        gs[mi][bj] = *(const u32x4*)(G + (size_t)row * 4096 + 2048 + col);
                        if (u.kind == 0) ga[mi][bj] = *(const u32x4*)(G + (size_t)row * 4096 + col);
                        if (u.kind == 2) { const float* t = T + (size_t)row * 2048 + col; t0[mi][bj] = *(const f32x4*)t; t1[mi][bj] = *(const f32x4*)(t + 4); }
                    }
#pragma unroll
                for (int mi = 0; mi < 1; ++mi)
#pragma unroll
                    for (int bj = 0; bj < 2; ++bj) {
                        const int row = row0 + ai * 128 + (mp + mi) * 16, col = col0 + bj * 128;
                        f32x4 s0, s1; unpk8(gs[mi][bj], s0, s1);
                        f32x4& v0 = acc[ai][bj][mp + mi][0]; f32x4& v1 = acc[ai][bj][mp + mi][1];
                        if (u.kind == 0) {
                            f32x4 a0, a1; unpk8(ga[mi][bj], a0, a1);
                            s0 = __builtin_elementwise_max(s0, tiny); s1 = __builtin_elementwise_max(s1, tiny);
                            v0 = v0 * (a0 / s0); v1 = v1 * (a1 / s1);
                        } else if (u.kind == 1) {
                            s0 = __builtin_elementwise_max(s0, tiny); s1 = __builtin_elementwise_max(s1, tiny);
                            *(u32x4*)(Mg + (size_t)row * 2048 + col) = pk8(v0 * s0, v1 * s1);
                        } else {
                            *(u32x4*)(Mg + (size_t)row * 2048 + col) = pk8(t0[mi][bj] + s0 * v0, t1[mi][bj] + s1 * v1);
                        }
                    }
            }
        return u.kind == 0;
    }
};
struct F6 {
    struct Pre { f32x4 x0, x1; };
    const float *xp, *xs; float* X; float* PART;
    __device__ __forceinline__ void pre(int row, int col, int pk, Pre& p) const {
        if (!pk) { const float* x = (row < 8192 ? xp + (size_t)row * 2048 : xs + (size_t)(row - 8192) * 2048) + col; p.x0 = *(const f32x4*)x; p.x1 = *(const f32x4*)(x + 4); }
    }
    __device__ __forceinline__ void post(int row, int col, f32x4 v0, f32x4 v1, int pk, const Pre& p) const {
        if (pk) { *(u32x4*)((bf16_t*)PART + ((size_t)(pk - 1) * 1024 + (row - 8192)) * 2048 + col) = pk8(v0, v1); return; }
        float* o = X + (size_t)row * 2048 + col; *(f32x4*)o = p.x0 + v0; *(f32x4*)(o + 4) = p.x1 + v1;
    }
};
struct F8 {
    typedef NoPre Pre;
    bf16_t* ACT;
    __device__ __forceinline__ void pre(int, int, int, Pre&) const {}
    __device__ __forceinline__ void post(int row, int col, f32x4 v0, f32x4 v1, int, const Pre&) const {
        const f32x4 z = {0.f, 0.f, 0.f, 0.f}; f32x4 a = __builtin_elementwise_max(v0, z), b = __builtin_elementwise_max(v1, z);
        *(u32x4*)(ACT + (size_t)row * DFF + col) = pk8(a * a, b * b);
    }
};
struct F9 {
    struct Pre { f32x4 x0, x1; };
    float* X; float* PART;
    __device__ __forceinline__ void pre(int row, int col, int pk, Pre& p) const {
        if (!pk) { const float* o = X + (size_t)row * 2048 + col; p.x0 = *(const f32x4*)o; p.x1 = *(const f32x4*)(o + 4); }
    }
    __device__ __forceinline__ void post(int row, int col, f32x4 v0, f32x4 v1, int pk, const Pre& p) const {
        if (pk) { *(u32x4*)((bf16_t*)PART + ((size_t)(pk - 1) * 1024 + (row - 8192)) * 2048 + col) = pk8(v0, v1); return; }
        float* o = X + (size_t)row * 2048 + col; *(f32x4*)o = p.x0 + v0; *(f32x4*)(o + 4) = p.x1 + v1;
    }
};

__device__ __forceinline__ void transpose_item(const float* __restrict__ W, int K, int N, bf16_t* WT, LAS float* scr, int item, int lane) {
    const int nblk = N / 32, kb = item / nblk, nb = item % nblk, k0 = 64 * kb, n0 = 32 * nb;
    float wv[32];
#pragma unroll
    for (int i = 0; i < 32; ++i) wv[i] = W[(size_t)(k0 + 2 * i + (lane >> 5)) * N + n0 + (lane & 31)];
#pragma unroll
    for (int i = 0; i < 32; ++i) scr[(2 * i + (lane >> 5)) * 33 + (lane & 31)] = wv[i];
    LDS_WAIT();
    const int c = lane & 7;
#pragma unroll
    for (int j = 0; j < 4; ++j) { const int n = (lane >> 3) + 8 * j; const LAS float* s = scr + (8 * c) * 33 + n;
        u32x4 o; o.x = pk2(s[0 * 33], s[1 * 33]); o.y = pk2(s[2 * 33], s[3 * 33]); o.z = pk2(s[4 * 33], s[5 * 33]); o.w = pk2(s[6 * 33], s[7 * 33]);
        *(u32x4*)(WT + (size_t)(n0 + n) * K + k0 + 8 * c) = o; }
    LDS_WAIT();
}
__device__ __forceinline__ void convert_tail(const float* __restrict__ W, int K, int N, bf16_t* WT, int item0, int nitems, int ntiles, int G, int bx, int wave, int lane, LAS float* scr) {
    const int maxu = (ntiles + G - 1) / G, first_idle = ntiles - (maxu - 1) * G, nidle = G - first_idle;
    if (nidle >= 32) { if (bx >= first_idle) for (int it = item0 + (bx - first_idle) * 8 + wave; it < nitems; it += nidle * 8) transpose_item(W, K, N, WT, scr, it, lane); }
    else for (int it = item0 + bx * 8 + wave; it < nitems; it += G * 8) transpose_item(W, K, N, WT, scr, it, lane);
}
__device__ __forceinline__ void rms_row(const float* xrow, const float* __restrict__ g, bf16_t* ob, float* of, int lane, const float* part = nullptr, float* xw = nullptr) {
    f32x4 v[8]; float s = 0.f;
#pragma unroll
    for (int j = 0; j < 8; ++j) { v[j] = ((const f32x4*)xrow)[64 * j + lane];
        if (part) {
#pragma unroll
            for (int q = 0; q < 7; ++q) { const u32x2 w = ((const u32x2*)((const bf16_t*)part + (size_t)q * 1024 * 2048))[64 * j + lane]; v[j] += (f32x4){bf_lo(w.x), bf_hi(w.x), bf_lo(w.y), bf_hi(w.y)}; }
            if (xw) ((f32x4*)xw)[64 * j + lane] = v[j]; }
        s += (v[j][0] * v[j][0] + v[j][1] * v[j][1]) + (v[j][2] * v[j][2] + v[j][3] * v[j][3]); }
    const float rstd = 1.f / sqrtf(wave_sum(s) * (1.f / 2048.f) + 1e-5f);
#pragma unroll
    for (int j = 0; j < 8; ++j) { const f32x4 gg = ((const f32x4*)g)[64 * j + lane]; const f32x4 y = v[j] * rstd * gg;
        if (ob) ((u32x2*)ob)[64 * j + lane] = (u32x2){pk2(y[0], y[1]), pk2(y[2], y[3])}; else ((f32x4*)of)[64 * j + lane] = y; }
}

constexpr int KS_PITCH = 144, VT_PITCH = 424, LDS_VT_OFF = 192 * KS_PITCH;
__device__ __forceinline__ void attn_unit(const Params& P, int unit, LAS unsigned char* lds, int tid, int wave, int lane, bool dry) {
    bf16_t* Qb = (bf16_t*)(P.ws + WS_Q); const bf16_t* Kb = (const bf16_t*)(P.ws + WS_K); const bf16_t* Vb = (const bf16_t*)(P.ws + WS_V);
    const int ui = unit >> 8, ub = unit & 255, ur = (ui >> 1) * 256 + ub; const bool sample = ((ui + ub) & 1); const int kvh = ur & 3, blk = ur >> 2;
    LAS unsigned char* Ks = lds; LAS unsigned char* Vt = lds + LDS_VT_OFF;
    const int ntask = sample ? 4 : 16, r16 = lane & 15, quad = lane >> 4;
    bf16x8 qf[2][2];
#pragma unroll
    for (int j = 0; j < 2; ++j) {
        const int task = wave + 8 * j;
        if (task < ntask) {
            const int qrow = sample ? (8192 + 8 * blk + (r16 & 7)) : (64 * blk + 16 * (task >> 2) + r16);
            const bf16_t* qq = Qb + (size_t)qrow * 1024 + (kvh * 4 + (task & 3)) * 64;
            qf[j][0] = *(const bf16x8*)(qq + quad * 8); qf[j][1] = *(const bf16x8*)(qq + 32 + quad * 8);
        }
    }
    for (int idx = tid; idx < 192 * 8; idx += 512) {
        const int key = idx >> 3, ch = idx & 7;
        u32x4 kv = {0u, 0u, 0u, 0u}, vv = {0u, 0u, 0u, 0u};
        if (!sample) {
            const int pos = 64 * blk - 112 + key;
            if (pos >= 0) { const int row = pos < 16 ? 9216 + pos : pos - 16; kv = *(const u32x4*)(Kb + (size_t)row * 256 + kvh * 64 + ch * 8); vv = *(const u32x4*)(Vb + (size_t)row * 256 + kvh * 64 + ch * 8); }
        } else if (key < 128) {
            const size_t o = ((size_t)(blk * 128 + key) * 4 + kvh) * 64 + ch * 8;
            const float* pk = P.in[2] + o; const float* pv = P.in[3] + o;
            kv = pk8(*(const f32x4*)pk, *(const f32x4*)(pk + 4)); vv = pk8(*(const f32x4*)pv, *(const f32x4*)(pv + 4));
        } else if (key < 136) {
            const int row = 8192 + 8 * blk + key - 128; kv = *(const u32x4*)(Kb + (size_t)row * 256 + kvh * 64 + ch * 8); vv = *(const u32x4*)(Vb + (size_t)row * 256 + kvh * 64 + ch * 8);
        }
        *(LAS u32x4*)(Ks + key * KS_PITCH + ch * 16) = kv;
        LAS unsigned short* vt = (LAS unsigned short*)(Vt + (ch * 8) * VT_PITCH + key * 2);
        vt[0 * (VT_PITCH / 2)] = (unsigned short)(vv.x & 0xffffu); vt[1 * (VT_PITCH / 2)] = (unsigned short)(vv.x >> 16);
        vt[2 * (VT_PITCH / 2)] = (unsigned short)(vv.y & 0xffffu); vt[3 * (VT_PITCH / 2)] = (unsigned short)(vv.y >> 16);
        vt[4 * (VT_PITCH / 2)] = (unsigned short)(vv.z & 0xffffu); vt[5 * (VT_PITCH / 2)] = (unsigned short)(vv.z >> 16);
        vt[6 * (VT_PITCH / 2)] = (unsigned short)(vv.w & 0xffffu); vt[7 * (VT_PITCH / 2)] = (unsigned short)(vv.w >> 16);
    }
    for (int idx = tid; idx < 64 * 20; idx += 512) { const int d = idx / 20, k = 192 + idx % 20; *(LAS unsigned short*)(Vt + d * VT_PITCH + k * 2) = 0; }
    __syncthreads();
#pragma unroll 1
    for (int j = 0; j < 2; ++j) {
        const int task = wave + 8 * j; if (task >= ntask) break;
        const int head = kvh * 4 + (task & 3), tql = 16 * (task >> 2);
        const int qrow = sample ? (8192 + 8 * blk + (r16 & 7)) : (64 * blk + tql + r16);
        bf16_t* qp = Qb + (size_t)qrow * 1024 + head * 64;
        const bf16x8 q0 = j ? qf[1][0] : qf[0][0], q1 = j ? qf[1][1] : qf[0][1];
        const float slope = exp2f(-0.5f * (float)(head + 1)), sink = P.in[9][head];
        float s[10][4]; float mx = -1e30f;
#pragma unroll
        for (int kb = 0; kb < 9; ++kb) {
            const LAS unsigned char* kp = Ks + (tql + kb * 16 + r16) * KS_PITCH + quad * 16;
            const bf16x8 a0 = *(const LAS bf16x8*)kp, a1 = *(const LAS bf16x8*)(kp + 64);
            f32x4 acc = {0.f, 0.f, 0.f, 0.f};
            acc = __builtin_amdgcn_mfma_f32_16x16x32_bf16(a0, q0, acc, 0, 0, 0);
            acc = __builtin_amdgcn_mfma_f32_16x16x32_bf16(a1, q1, acc, 0, 0, 0);
#pragma unroll
            for (int i = 0; i < 4; ++i) {
                const int kin = kb * 16 + quad * 4 + i, kl = tql + kin, dist = 128 + r16 - kin;
                const bool kvalid = sample ? (kl < 136) : (64 * blk - 112 + kl >= 0);
                const bool valid = dist >= 0 && dist <= 128 && kvalid;
                const float sv = valid ? acc[i] - slope * (float)dist : -1e30f;
                s[kb][i] = sv; mx = fmaxf(mx, sv);
            }
        }
        mx = fmaxf(mx, __shfl_xor(mx, 16)); mx = fmaxf(mx, __shfl_xor(mx, 32)); mx = fmaxf(mx, sink);
        float sum = 0.f;
#pragma unroll
        for (int kb = 0; kb < 9; ++kb)
#pragma unroll
            for (int i = 0; i < 4; ++i) { const float p = __expf(s[kb][i] - mx); s[kb][i] = p; sum += p; }
#pragma unroll
        for (int i = 0; i < 4; ++i) s[9][i] = 0.f;
        sum += __shfl_xor(sum, 16); sum += __shfl_xor(sum, 32);
        const float inv = 1.f / (sum + __expf(sink - mx));
        f32x4 o[4];
#pragma unroll
        for (int db = 0; db < 4; ++db) o[db] = (f32x4){0.f, 0.f, 0.f, 0.f};
#pragma unroll
        for (int pp = 0; pp < 5; ++pp) {
            u32x4 pw; pw.x = pk2(s[2 * pp][0], s[2 * pp][1]); pw.y = pk2(s[2 * pp][2], s[2 * pp][3]); pw.z = pk2(s[2 * pp + 1][0], s[2 * pp + 1][1]); pw.w = pk2(s[2 * pp + 1][2], s[2 * pp + 1][3]);
            const bf16x8 pb = __builtin_bit_cast(bf16x8, pw);
#pragma unroll
            for (int db = 0; db < 4; ++db) {
                const LAS unsigned char* vp = Vt + (db * 16 + r16) * VT_PITCH + (tql + pp * 32 + quad * 4) * 2;
                const u32x2 lo = *(const LAS u32x2*)vp, hi = *(const LAS u32x2*)(vp + 32);
                const u32x4 vw = {lo.x, lo.y, hi.x, hi.y};
                o[db] = __builtin_amdgcn_mfma_f32_16x16x32_bf16(__builtin_bit_cast(bf16x8, vw), pb, o[db], 0, 0, 0);
            }
        }
        if ((!sample || r16 < 8) && !dry) {
#pragma unroll
            for (int db = 0; db < 4; ++db) { const f32x4 v = o[db] * inv; *(u32x2*)(qp + db * 16 + quad * 4) = (u32x2){pk2(v[0], v[1]), pk2(v[2], v[3])}; }
        }
    }
    __syncthreads();
}

constexpr int BU_PITCH = 528, HS_PITCH = 272, SSM_WL = 16 * BU_PITCH + 16 * HS_PITCH;
struct SsmM { float ar, ai; bf16x8 bf[8]; };
__device__ __forceinline__ void ssm_load_m(const Params& P, int g, int lane, SsmM& C) {
    const f32x2 ab = ((const f32x2*)(P.ws + WS_AB))[g * 64 + lane]; C.ar = ab[0]; C.ai = ab[1];
    const int r16 = lane & 15, quad = lane >> 4, c0 = (quad & 1) * 8;
    const f32x2* bb = (const f32x2*)(P.ws + WS_BB) + (size_t)g * 16 * 64;
#pragma unroll
    for (int blk = 0; blk < 8; ++blk) {
        const int p = (16 * blk + r16) & 63; float v[8];
#pragma unroll
        for (int j = 0; j < 8; ++j) { const f32x2 e = bb[(c0 + j) * 64 + p]; v[j] = blk >= 4 ? e[1] : e[0]; }
        C.bf[blk] = __builtin_bit_cast(bf16x8, pk8((f32x4){v[0], v[1], v[2], v[3]}, (f32x4){v[4], v[5], v[6], v[7]}));
    }
}
struct URaw { f32x4 a[4], b[4]; };
__device__ __forceinline__ void ssm_fetch_raw(const Params& P, int row0, int L, int g, int lane, URaw& u) {
    const float* U = (const float*)(P.ws + WS_U); const int r16 = lane & 15, quad = lane >> 4;
#pragma unroll
    for (int sb = 0; sb < 4; ++sb) {
        const int tok = sb * 16 + r16;
        if (tok < L) { const float* src = U + (size_t)(row0 + tok) * 1024 + g * 16 + (quad & 1) * 8; u.a[sb] = *(const f32x4*)src; u.b[sb] = *(const f32x4*)(src + 4); }
        else { u.a[sb] = (f32x4){0.f, 0.f, 0.f, 0.f}; u.b[sb] = (f32x4){0.f, 0.f, 0.f, 0.f}; }
    }
}
__device__ __forceinline__ void ssm_bu_block(const SsmM& C, f32x4 a, f32x4 b, LAS unsigned char* BU, int r16, int quad) {
    const u32x4 hi = pk8(a, b); f32x4 ha, hb; unpk8(hi, ha, hb); const u32x4 lo = pk8(a - ha, b - hb);
    const bf16x8 uf = __builtin_bit_cast(bf16x8, quad >= 2 ? lo : hi);
#pragma unroll
    for (int blk = 0; blk < 8; ++blk) {
        f32x4 d = {0.f, 0.f, 0.f, 0.f}; d = __builtin_amdgcn_mfma_f32_16x16x32_bf16(C.bf[blk], uf, d, 0, 0, 0);
        *(LAS f32x4*)(BU + r16 * BU_PITCH + blk * 64 + quad * 16) = d;
    }
    LDS_WAIT();
}
__device__ __forceinline__ void ssm_rec(const SsmM& C, const LAS unsigned char* BU, int t, int lane, float& hr, float& hi) {
    const float br = *(const LAS float*)(BU + t * BU_PITCH + lane * 4), bi = *(const LAS float*)(BU + t * BU_PITCH + 256 + lane * 4);
    const float nr = fmaf(C.ar, hr, fmaf(-C.ai, hi, br)), ni = fmaf(C.ar, hi, fmaf(C.ai, hr, bi));
    hr = nr; hi = ni;
}
template <int NT> __device__ __forceinline__ void ssm_rec_block(const SsmM& C, const LAS unsigned char* BU, LAS unsigned char* Hs, int lane, float& hr, float& hi) {
#pragma unroll
    for (int t = 0; t < NT; ++t) {
        ssm_rec(C, BU, t, lane, hr, hi);
        const unsigned w = pk2(hr, hi);
        *(LAS unsigned short*)(Hs + t * HS_PITCH + lane * 2) = (unsigned short)(w & 0xffffu);
        *(LAS unsigned short*)(Hs + t * HS_PITCH + 128 + lane * 2) = (unsigned short)(w >> 16);
    }
}
__device__ __forceinline__ void ssm_passA(const Params& P, int g, int slot, int nslots, LAS unsigned char* wl, int lane) {
    const int r16 = lane & 15, quad = lane >> 4;
    SsmM C; ssm_load_m(P, g, lane, C);
    URaw cur, nxt; int c = slot;
    if (c < 129) ssm_fetch_raw(P, c == 0 ? 9216 : 64 * (c - 1), c == 0 ? 16 : 64, g, lane, cur);
    for (; c < 129; c += nslots) {
        const int L = c == 0 ? 16 : 64, cn = c + nslots;
        if (cn < 129) ssm_fetch_raw(P, 64 * (cn - 1), 64, g, lane, nxt);
        float hr = 0.f, hi = 0.f;
#pragma unroll
        for (int sb = 0; sb < 4; ++sb) if (sb * 16 < L) {
            ssm_bu_block(C, cur.a[sb], cur.b[sb], wl, r16, quad);
#pragma unroll
            for (int t = 0; t < 16; ++t) ssm_rec(C, wl, t, lane, hr, hi);
            LDS_WAIT();
        }
        ((f32x2*)(P.ws + WS_E))[(size_t)(c * 64 + g) * 64 + lane] = (f32x2){hr, hi};
        cur = nxt;
    }
}
__device__ __forceinline__ void ssm_passB(const Params& P, int g, int slot, int nslots, LAS unsigned char* wl, int lane) {
    LAS unsigned char* Hs = wl + 16 * BU_PITCH;
    SsmM C; ssm_load_m(P, g, lane, C);
    const int r16 = lane & 15, quad = lane >> 4;
    bf16x8 cf[4];
#pragma unroll
    for (int cc = 0; cc < 4; ++cc) {
        const float* src = (cc < 2 ? P.in[15] : P.in[16]) + (size_t)(g * 16 + r16) * 64 + (cc & 1) * 32 + quad * 8;
        f32x4 a = *(const f32x4*)src, bq = *(const f32x4*)(src + 4); if (cc >= 2) { a = -a; bq = -bq; }
        cf[cc] = __builtin_bit_cast(bf16x8, pk8(a, bq));
    }
    const f32x4 dd = *(const f32x4*)(P.in[17] + g * 16 + quad * 4);
    bf16_t* Z = (bf16_t*)(P.ws + WS_Z); const float* U = (const float*)(P.ws + WS_U);
    URaw cur, nxt; int it = slot;
    if (it < 256) ssm_fetch_raw(P, it < 128 ? 64 * it : 8192 + 8 * (it - 128), it < 128 ? 64 : 8, g, lane, cur);
    for (; it < 256; it += nslots) {
        const bool sample = it >= 128; const int b = it - 128;
        const int row0 = sample ? 8192 + 8 * b : 64 * it, L = sample ? 8 : 64;
        float hr, hi;
        if (sample) { hr = P.in[4][(size_t)(b * 64 + g) * 64 + lane]; hi = P.in[5][(size_t)(b * 64 + g) * 64 + lane]; }
        else { const f32x2 e0 = ((const f32x2*)(P.ws + WS_E))[(size_t)(it * 64 + g) * 64 + lane]; hr = e0[0]; hi = e0[1]; }
        const int in = it + nslots; if (in < 256) ssm_fetch_raw(P, in < 128 ? 64 * in : 8192 + 8 * (in - 128), in < 128 ? 64 : 8, g, lane, nxt);
#pragma unroll
        for (int sb = 0; sb < 4; ++sb) if (sb * 16 < L) {
            const int tok = sb * 16 + r16;
            f32x4 u4 = {0.f, 0.f, 0.f, 0.f}; if (tok < L) u4 = *(const f32x4*)(U + (size_t)(row0 + tok) * 1024 + g * 16 + quad * 4);
            ssm_bu_block(C, cur.a[sb], cur.b[sb], wl, r16, quad);
            if (sample) ssm_rec_block<8>(C, wl, Hs, lane, hr, hi); else ssm_rec_block<16>(C, wl, Hs, lane, hr, hi);
            LDS_WAIT();
            f32x4 acc = {0.f, 0.f, 0.f, 0.f};
#pragma unroll
            for (int cc = 0; cc < 4; ++cc) { const bf16x8 hb = *(const LAS bf16x8*)(Hs + r16 * HS_PITCH + cc * 64 + quad * 16); acc = __builtin_amdgcn_mfma_f32_16x16x32_bf16(cf[cc], hb, acc, 0, 0, 0); }
            if (tok < L) {
                const f32x4 y = acc + dd * u4;
                *(u32x2*)(Z + (size_t)(row0 + tok) * 1024 + g * 16 + quad * 4) = (u32x2){pk2(gelu_tanh(y[0]), gelu_tanh(y[1])), pk2(gelu_tanh(y[2]), gelu_tanh(y[3]))};
            }
            LDS_WAIT();
        }
        if (sample) { P.out[O_SRS + (size_t)(b * 64 + g) * 64 + lane] = hr; P.out[O_SIS + (size_t)(b * 64 + g) * 64 + lane] = hi; }
        else if (it == 127) { P.out[O_SRP + g * 64 + lane] = hr; P.out[O_SIP + g * 64 + lane] = hi; }
        cur = nxt;
    }
}

#define XB_TMO      128
#define XB_XCNT(j)  (256  + 64 * (j))
#define XB_XSUB(j)  (1280 + 64 * (j))
#define XB_XGEN(j)  (2304 + 64 * (j))
#define XB_TOP      3328
#define XB_TOPGEN   3392
#define XCD_BAR_WORDS 3456
#define XB_SPIN_CAP (1u << 18)

__device__ __forceinline__ unsigned xb_ld(unsigned* p)              { return __hip_atomic_load(p, __ATOMIC_RELAXED, __HIP_MEMORY_SCOPE_AGENT); }
__device__ __forceinline__ unsigned xb_add(unsigned* p, unsigned v) { return __hip_atomic_fetch_add(p, v, __ATOMIC_RELAXED, __HIP_MEMORY_SCOPE_AGENT); }
__device__ __forceinline__ unsigned xb_xcc_id() { return (unsigned)__builtin_amdgcn_s_getreg((3 << 11) | 20) & 0xFu; }
#define XB_SPIN(cond, bar) do { unsigned _sp = 0; while (cond) { __builtin_amdgcn_s_sleep(1); \
    if ((++_sp & 255u) == 0u) { if (xb_ld(&(bar)[XB_TMO])) break; if (_sp > XB_SPIN_CAP) { atomicAdd(&(bar)[XB_TMO], 1u); break; } } } } while (0)

struct XcdBarrier {
    unsigned* bar; unsigned x;
    volatile LAS unsigned* st;
};

__device__ __forceinline__ XcdBarrier xcd_barrier_post(unsigned* bar, volatile LAS unsigned* st) {
    XcdBarrier b; b.bar = bar; b.x = xb_xcc_id(); b.st = st;
    if (threadIdx.x == 0) (void)xb_add(&bar[XB_XCNT(b.x)], 1u);
    return b;
}
__device__ __forceinline__ void xcd_barrier_complete(unsigned* bar, unsigned x, unsigned& nloc, unsigned& nx) {
    const unsigned G = gridDim.x * gridDim.y * gridDim.z;
    unsigned sum, cnt, mine, sp = 0u;
    for (;;) {
        sum = 0u; cnt = 0u; mine = 0u;
#pragma unroll
        for (unsigned j = 0; j < 16; ++j) { const unsigned c = xb_ld(&bar[XB_XCNT(j)]); sum += c; cnt += (c > 0u) ? 1u : 0u; mine = (j == x) ? c : mine; }
        if (sum == G) break;
        __builtin_amdgcn_s_sleep(1);
        if ((++sp & 255u) == 0u) { if (xb_ld(&bar[XB_TMO])) break; if (sp > XB_SPIN_CAP) { atomicAdd(&bar[XB_TMO], 1u); break; } }
    }
    nloc = mine > 0u ? mine : 1u; nx = cnt > 0u ? cnt : 1u;
}

__device__ __forceinline__ void xcd_barrier(const XcdBarrier& b) {
    asm volatile("s_waitcnt vmcnt(0)" ::: "memory");
    __syncthreads();
    if (threadIdx.x == 0) {
        unsigned* bar = b.bar;
        __builtin_amdgcn_s_waitcnt(0);
        unsigned nloc = b.st[0], nx = b.st[1];
        if (nloc == 0u) { xcd_barrier_complete(bar, b.x, nloc, nx); b.st[0] = nloc; b.st[1] = nx; }
        const unsigned old = xb_add(&bar[XB_XSUB(b.x)], 1u);
        const unsigned gen = old / nloc;
        if (old + 1u == (gen + 1u) * nloc) {
            __builtin_amdgcn_fence(__ATOMIC_RELEASE, "agent");
            asm volatile("s_waitcnt vmcnt(0)" ::: "memory");
            const unsigned og = xb_add(&bar[XB_TOP], 1u);
            const unsigned tg = og / nx;
            if (og + 1u == (tg + 1u) * nx) xb_add(&bar[XB_TOPGEN], 1u);
            else XB_SPIN(xb_ld(&bar[XB_TOPGEN]) == tg, bar);
            __builtin_amdgcn_fence(__ATOMIC_ACQUIRE, "agent");
            xb_add(&bar[XB_XGEN(b.x)], 1u);
            asm volatile("s_waitcnt vmcnt(0)" ::: "memory");
        } else {
            XB_SPIN(xb_ld(&bar[XB_XGEN(b.x)]) == gen, bar);
            __builtin_amdgcn_fence(__ATOMIC_ACQUIRE, "agent");
            asm volatile("s_waitcnt vmcnt(0)" ::: "memory");
        }
    }
    __syncthreads();
}

__global__ void __launch_bounds__(512, 2) mega_fwd(Params P) {
    extern __shared__ __attribute__((aligned(16))) unsigned char lds_raw[];
    LAS unsigned char* lds = (LAS unsigned char*)lds_raw;
    cg::grid_group grid = cg::this_grid();
    const int tid = threadIdx.x, lane = tid & 63, wave = __builtin_amdgcn_readfirstlane(tid >> 6);
    const int G = gridDim.x, bx = blockIdx.x, gw = bx * 8 + wave, NGW = G * 8;
    unsigned char* ws = P.ws; float* out = P.out;
    unsigned long long pt0 = 0, pdur = 0;
    unsigned* barw = (unsigned*)(ws + WS_BAR);
    if (bx == 0) for (int i = tid; i < XCD_BAR_WORDS; i += 512) barw[i] = 0u;
    volatile LAS unsigned* bst = (volatile LAS unsigned*)(lds + 131072);
    if (tid < 2) bst[tid] = 0u;
    __syncthreads();
    grid.sync();
    const XcdBarrier xb = xcd_barrier_post(barw, bst);
#define PSTART(k) do { if (PROBE == (k) + 1) pt0 = __builtin_amdgcn_s_memrealtime(); } while (0)
#define PEND(k) do { if (PROBE == (k) + 1) pdur = __builtin_amdgcn_s_memrealtime() - pt0; } while (0)
    bf16_t* Hb = (bf16_t*)(ws + WS_H);

    PSTART(0);
    {
        LAS float* scr = (LAS float*)(lds + wave * 16384);
        constexpr int I_IN = 32 * 208, I_GLU = 16 * 32, I_A = 16 * 64, I_S = 16 * 64, I_OUT = 32 * 64, I_UP = 32 * 256, I_DN = 128 * 64;
        for (int it = gw; it < I_IN + UP_P0; it += NGW) {
            if (it < I_IN) transpose_item(P.in[8], 2048, INC, (bf16_t*)(ws + WS_WIN), scr, it, lane);
            else transpose_item(P.in[24], 2048, DFF, (bf16_t*)(ws + WS_WUP), scr, it - I_IN, lane);
        }
        for (int m = gw; m < MP; m += NGW) {
            if (m < M1) { const float* x = m < 8192 ? P.in[0] + (size_t)m * 2048 : (m < 9216 ? P.in[1] + (size_t)(m - 8192) * 2048 : P.in[6] + (size_t)(m - 9216) * 2048);
                rms_row(x, P.in[7], Hb + (size_t)m * 2048, nullptr, lane); }
            else { for (int j = 0; j < 4; ++j) ((u32x4*)(Hb + (size_t)m * 2048))[64 * j + lane] = (u32x4){0u, 0u, 0u, 0u}; }
        }
        for (int idx = bx * 512 + tid; idx < 65536; idx += G * 512) {
            const int p = idx & 63, c = (idx >> 6) & 15, g = idx >> 10, gp = g * 64 + p;
            const float are = P.in[10][gp], aim = P.in[11][gp], dt = expf(P.in[12][g]);
            const float mag = expf(dt * are), abr = mag * cosf(dt * aim), abi = mag * sinf(dt * aim);
            const float nr = abr - 1.f, ni = abi, den = are * are + aim * aim, fr = (nr * are + ni * aim) / den, fi = (ni * are - nr * aim) / den;
            if (c == 0) ((f32x2*)(ws + WS_AB))[gp] = (f32x2){abr, abi};
            const float br = P.in[13][(size_t)gp * 16 + c], bi = P.in[14][(size_t)gp * 16 + c];
            ((f32x2*)(ws + WS_BB))[(size_t)(g * 16 + c) * 64 + p] = (f32x2){fr * br - fi * bi, fr * bi + fi * br};
        }
    }
    xcd_barrier(xb);
    PEND(0);
    PSTART(1);
    {
        pg8::Gemm g{Hb, (const bf16_t*)(ws + WS_WIN), MP, INC, 2048, nullptr, nullptr}; pg8::StaticOrder S; S.init(MP, INC, G, bx, 32);
        Epi<F1> E{F1{(bf16_t*)(ws + WS_Q), (bf16_t*)(ws + WS_K), (bf16_t*)(ws + WS_V), (bf16_t*)(ws + WS_G), (float*)(ws + WS_U), out}};
        pg8::gemm_phase<Epi<F1>, pg8::StaticOrder, true, true>(lds, g, S, E);
        convert_tail(P.in[24], 2048, DFF, (bf16_t*)(ws + WS_WUP), UP_P0, 32 * 256 - UP_P5, (MP / 256) * (INC / 256), G, bx, wave, lane, (LAS float*)(lds + wave * 16384));
    }
    xcd_barrier(xb);
    PEND(1);
    PSTART(2);
    {
        for (int u = bx; u < 1024; u += G) attn_unit(P, u, lds, tid, wave, lane, false);
        LAS unsigned char* wl = lds + wave * SSM_WL;
        if (gw < (NGW / 64) * 64) ssm_passA(P, gw & 63, gw >> 6, NGW / 64, wl, lane);
    }
    xcd_barrier(xb);
    PEND(2);
    PSTART(11);
    {
        if (bx < 64) {
            const int g = bx; const f32x2 ab = ((const f32x2*)(ws + WS_AB))[g * 64 + lane];
            float pr = ab[0], pi = ab[1];
#pragma unroll
            for (int k = 0; k < 6; ++k) { const float nr = pr * pr - pi * pi, ni = 2.f * pr * pi; pr = nr; pi = ni; }
            float qr = pr, qi = pi;
#pragma unroll
            for (int k = 0; k < 4; ++k) { const float nr = qr * qr - qi * qi, ni = 2.f * qr * qi; qr = nr; qi = ni; }
            f32x2* E = (f32x2*)(ws + WS_E) + (size_t)g * 64 + lane;
            f32x2 e[16];
#pragma unroll
            for (int k = 0; k < 16; ++k) e[k] = E[(size_t)(16 * wave + k) * 4096];
            float hr = 0.f, hi = 0.f;
#pragma unroll
            for (int k = 0; k < 16; ++k) { const float nr = fmaf(pr, hr, fmaf(-pi, hi, e[k][0])), ni = fmaf(pr, hi, fmaf(pi, hr, e[k][1])); hr = nr; hi = ni; e[k] = (f32x2){hr, hi}; }
            LAS f32x2* F = (LAS f32x2*)lds;
            F[wave * 64 + lane] = (f32x2){hr, hi};
            __syncthreads();
            float cr = 0.f, ci = 0.f;
            for (int v = 0; v < wave; ++v) { const f32x2 f = F[v * 64 + lane]; const float nr = fmaf(qr, cr, fmaf(-qi, ci, f[0])), ni = fmaf(qr, ci, fmaf(qi, cr, f[1])); cr = nr; ci = ni; }
#pragma unroll
            for (int k = 0; k < 16; ++k) {
                const float nr = pr * cr - pi * ci, ni = pr * ci + pi * cr; cr = nr; ci = ni;
                if (16 * wave + k >= 1) E[(size_t)(16 * wave + k) * 4096] = (f32x2){e[k][0] + cr, e[k][1] + ci};
            }
            __syncthreads();
        }
        {
            constexpr int J_GLU = 16 * 32, J_A = 16 * 64, J_S = 16 * 64, J_OUT = 32 * 64;
            const int b0 = G > 64 ? 64 : 0, nw = (G - b0) * 8; LAS float* scr = (LAS float*)(lds + wave * 16384);
            if (bx >= b0) for (int it = (bx - b0) * 8 + wave; it < J_GLU + J_A + J_S + J_OUT; it += nw) {
                int r = it;
                if (r < J_GLU) { transpose_item(P.in[18], 1024, 1024, (bf16_t*)(ws + WS_WGLU), scr, r, lane); continue; } r -= J_GLU;
                if (r < J_A) { transpose_item(P.in[20], 1024, 2048, (bf16_t*)(ws + WS_WA), scr, r, lane); continue; } r -= J_A;
                if (r < J_S) { transpose_item(P.in[21], 1024, 2048, (bf16_t*)(ws + WS_WS), scr, r, lane); continue; } r -= J_S;
                transpose_item(P.in[22], 2048, 2048, (bf16_t*)(ws + WS_WOUT), scr, r, lane);
            }
        }
    }
    xcd_barrier(xb);
    PEND(11);
    PSTART(3);
    {
        LAS unsigned char* wl = lds + wave * SSM_WL;
        {
            const int gt = bx * 512 + tid, NGT = G * 512; constexpr int NC = 2 * 128 * 120 * 64;
            for (int i0 = gt; i0 < NC; i0 += 5 * NGT) {
                f32x4 v[5];
#pragma unroll
                for (int q = 0; q < 5; ++q) { const int i = i0 + q * NGT; if (i < NC) { const int which = i / (128 * 120 * 64), r = i % (128 * 120 * 64), bw = r >> 6, c4 = r & 63, b = bw / 120, w = bw % 120;
                    v[q] = *(const f32x4*)(P.in[2 + which] + ((size_t)(b * 128 + w + 8)) * 256 + c4 * 4); } }
#pragma unroll
                for (int q = 0; q < 5; ++q) { const int i = i0 + q * NGT; if (i < NC) { const int which = i / (128 * 120 * 64), r = i % (128 * 120 * 64), bw = r >> 6, c4 = r & 63, b = bw / 120, w = bw % 120;
                    *(f32x4*)(out + (which ? O_VS : O_KS) + ((size_t)(b * 128 + w)) * 256 + c4 * 4) = v[q]; } }
            }
        }
        if (gw < (NGW / 64) * 64) ssm_passB(P, gw & 63, gw >> 6, NGW / 64, wl, lane);
    }
    xcd_barrier(xb);
    PEND(3);
    PSTART(4);
    {
        pg8::Gemm g{(const bf16_t*)(ws + WS_Z), (const bf16_t*)(ws + WS_WGLU), M2, 1024, 1024, (const bf16_t*)(ws + WS_Q), (const bf16_t*)(ws + WS_WA)}; SchedP4 S{G, bx};
        Epi<F45> E{F45{(const bf16_t*)(ws + WS_Z), P.in[19], (bf16_t*)(ws + WS_U), (const bf16_t*)(ws + WS_G), out + O_Y}};
        pg8::gemm_phase<Epi<F45>, SchedP4, true, true>(lds, g, S, E);
    }
    xcd_barrier(xb);
    PEND(4);
    PSTART(5);
    {
        pg8::Gemm g{(const bf16_t*)(ws + WS_Q), (const bf16_t*)(ws + WS_WA), M2, 2048, 1024, (const bf16_t*)(ws + WS_U), (const bf16_t*)(ws + WS_WS)}; SchedP5 S{G, bx};
        EpiP5 E{(const bf16_t*)(ws + WS_G), out + O_Y, Hb};
        pg8::gemm_phase<EpiP5, SchedP5, true, true>(lds, g, S, E);
        {
            const int b0 = (G == 256) ? 208 : 0, nb = G - b0; LAS float* scr = (LAS float*)(lds + wave * 16384);
            if (bx >= b0) for (int it = (bx - b0) * 8 + wave; it < UP_P5 + DN_P5; it += nb * 8) {
                if (it < UP_P5) transpose_item(P.in[24], 2048, DFF, (bf16_t*)(ws + WS_WUP), scr, 32 * 256 - UP_P5 + it, lane);
                else transpose_item(P.in[25], DFF, 2048, (bf16_t*)(ws + WS_WDN), scr, it - UP_P5, lane);
            }
        }
    }
    xcd_barrier(xb);
    PEND(5);
    PSTART(6);
    {
        Epi<F6> E{F6{P.in[0], P.in[1], out + O_Y, (float*)(ws + WS_R)}};
        pg8::Gemm g{Hb, (const bf16_t*)(ws + WS_WOUT), M2, 2048, 2048, nullptr, nullptr}; SchedSplit S; S.full.init(8192, 2048, G, bx, 32); S.rem = SchedRem{32, 8, 8, 4, G, bx};
        pg8::gemm_phase<Epi<F6>, SchedSplit, true, true>(lds, g, S, E);
    }
    xcd_barrier(xb);
    PEND(6);
    PSTART(7);
    if (NGW == 2048) {
        if (gw < 1024) { const int m = 8192 + gw; float* xr = out + O_Y + (size_t)m * 2048; rms_row(xr, P.in[23], Hb + (size_t)m * 2048, nullptr, lane, (const float*)((const bf16_t*)(ws + WS_R) + (size_t)(m - 8192) * 2048), xr); }
        else for (int k = 0; k < 8; ++k) { const int m = (gw - 1024) + 1024 * k; rms_row(out + O_Y + (size_t)m * 2048, P.in[23], Hb + (size_t)m * 2048, nullptr, lane); }
    } else
    for (int m = gw; m < M2; m += NGW) { float* xr = out + O_Y + (size_t)m * 2048;
        if (m < 8192) rms_row(xr, P.in[23], Hb + (size_t)m * 2048, nullptr, lane); else rms_row(xr, P.in[23], Hb + (size_t)m * 2048, nullptr, lane, (const float*)((const bf16_t*)(ws + WS_R) + (size_t)(m - 8192) * 2048), xr); }
    xcd_barrier(xb);
    PEND(7);
    PSTART(8);
    {
        pg8::Gemm g{Hb, (const bf16_t*)(ws + WS_WUP), M2, DFF, 2048, nullptr, nullptr}; pg8::StaticOrder S; S.init(M2, DFF, G, bx, 32);
        Epi<F8> E{F8{(bf16_t*)(ws + WS_ACT)}};
        pg8::gemm_phase<Epi<F8>, pg8::StaticOrder, true, true>(lds, g, S, E);
        convert_tail(P.in[25], DFF, 2048, (bf16_t*)(ws + WS_WDN), DN_P5, 128 * 64, (M2 / 256) * (DFF / 256), G, bx, wave, lane, (LAS float*)(lds + wave * 16384));
    }
    xcd_barrier(xb);
    PEND(8);
    PSTART(9);
    {
        Epi<F9> E{F9{out + O_Y, (float*)(ws + WS_WIN)}};
        pg8::Gemm g{(const bf16_t*)(ws + WS_ACT), (const bf16_t*)(ws + WS_WDN), M2, 2048, DFF, nullptr, nullptr}; SchedSplit S; S.full.init(8192, 2048, G, bx, 128); S.rem = SchedRem{32, 8, 8, 16, G, bx};
        pg8::gemm_phase<Epi<F9>, SchedSplit, true, true>(lds, g, S, E);
    }
    xcd_barrier(xb);
    PEND(9);
    PSTART(10);
    if (NGW == 2048) {
        if (gw < 1024) { const int m = 8192 + gw; float* xr = out + O_Y + (size_t)m * 2048; rms_row(xr, P.in[26], nullptr, xr, lane, (const float*)((const bf16_t*)(ws + WS_WIN) + (size_t)(m - 8192) * 2048), nullptr); }
        else for (int k = 0; k < 8; ++k) { const int m = (gw - 1024) + 1024 * k; float* xr = out + O_Y + (size_t)m * 2048; rms_row(xr, P.in[26], nullptr, xr, lane); }
    } else
    for (int m = gw; m < M2; m += NGW) { float* xr = out + O_Y + (size_t)m * 2048;
        if (m < 8192) rms_row(xr, P.in[26], nullptr, xr, lane); else rms_row(xr, P.in[26], nullptr, xr, lane, (const float*)((const bf16_t*)(ws + WS_WIN) + (size_t)(m - 8192) * 2048), nullptr); }
    if (PROBE) { xcd_barrier(xb); if (PROBE == 11) { pdur = __builtin_amdgcn_s_memrealtime() - pt0; }
        if (bx == 0 && tid == 0) { const unsigned long long t = __builtin_amdgcn_s_memrealtime(); while (__builtin_amdgcn_s_memrealtime() - t < pdur) __builtin_amdgcn_s_sleep(8); } }
}

extern "C" void kernel_launch(void* const* d_in, const int* in_sizes, int n_in, void* d_out, int out_size, void* d_ws, size_t ws_size, hipStream_t stream) {
    static int grid = 0;
    if (grid == 0) {
        if (n_in != 27 || out_size != 28385280 || ws_size < WS_END) { fprintf(stderr, "kernel_launch: unexpected shapes (n_in %d, out %d, ws %zu < %zu)\n", n_in, out_size, ws_size, (size_t)WS_END); grid = -1; return; }
        int dev = 0, cus = 0, per_cu = 0;
        hipGetDevice(&dev); hipDeviceGetAttribute(&cus, hipDeviceAttributeMultiprocessorCount, dev);
        if (hipFuncSetAttribute((const void*)mega_fwd, hipFuncAttributeMaxDynamicSharedMemorySize, LDS_BYTES) != hipSuccess) { fprintf(stderr, "kernel_launch: hipFuncSetAttribute failed\n"); grid = -1; return; }
        if (hipOccupancyMaxActiveBlocksPerMultiprocessor(&per_cu, (const void*)mega_fwd, 512, LDS_BYTES) != hipSuccess || per_cu < 1) { fprintf(stderr, "kernel_launch: occupancy query says %d\n", per_cu); (void)hipGetLastError(); per_cu = 1; }
        grid = cus * per_cu;
    }
    if (grid < 0) return;
    Params p{};
    for (int i = 0; i < 27; ++i) p.in[i] = (const float*)d_in[i];
    p.out = (float*)d_out; p.ws = (unsigned char*)d_ws;
    void* args[] = {&p};
    hipError_t e = hipLaunchCooperativeKernel((const void*)mega_fwd, dim3(grid), dim3(512), args, LDS_BYTES, stream);
    if (e != hipSuccess) fprintf(stderr, "cooperative launch failed: %s (grid %d)\n", hipGetErrorString(e), grid);
}
```

```cpp
#include <hip/hip_runtime.h>
#include <hip/hip_cooperative_groups.h>
#include <cstdio>
#include <cstdint>
namespace cg = cooperative_groups;
namespace pg8 {
#define PG8_LAS __attribute__((address_space(3)))
typedef unsigned short bf16_t;
typedef short bf16x8 __attribute__((ext_vector_type(8)));
typedef float f32x4 __attribute__((ext_vector_type(4)));
typedef unsigned u32x4 __attribute__((ext_vector_type(4)));
constexpr int BM = 256, BK = 64, HALF = 128, HTB = HALF * BK * 2  , STAGE_BYTES = 8 * HTB, NXCD = 8, WGM = 8;

__host__ __device__ __forceinline__ int lds_byte(int r, int c) { const int st = (r >> 4) * 2 + (c >> 5), rr = r & 15, cc = c & 31, ob = rr * 64 + cc * 2; return st * 1024 + (ob ^ (((ob >> 9) & 1) << 5)); }
__host__ __device__ __forceinline__ void stage_rc(int b, int& R, int& C) { const int st = b / 1024, sb = b % 1024, swz = sb ^ (((sb >> 9) & 1) << 5); R = (st >> 1) * 16 + swz / 64; C = (st & 1) * 32 + (swz % 64) / 2; }
__host__ __device__ __forceinline__ int perm32(int rho) { const int n = rho >> 4, i = rho & 15; return 8 * (i >> 2) + 4 * n + (i & 3); }

struct Unit { int pm, pn, pk, nt, koff, kind; };
struct Gemm { const bf16_t* A; const bf16_t* Bt; int M, N, K; const bf16_t* A2; const bf16_t* Bt2; };

struct StaticOrder {
    int nM, nN, nwg, G, c, nt;
    __host__ __device__ void init(int M, int N, int G_, int c_, int nt_) { nM = M / BM; nN = N / BM; nwg = nM * nN; G = G_; c = c_; nt = nt_; }
    __host__ __device__ bool next(int i, Unit& u) const {
        const long L = (long)i * G + c; if (L >= nwg) return false;
        int wgid = (int)L; { const int q = nwg / NXCD, r = nwg % NXCD, xcd = wgid % NXCD, off = wgid / NXCD; wgid = (xcd < r ? xcd * (q + 1) : r * (q + 1) + (xcd - r) * q) + off; }
        const int nig = WGM * nN, gid = wgid / nig, fm = gid * WGM, gsz = (nM - fm) < WGM ? (nM - fm) : WGM;
        u.pm = fm + ((wgid % nig) % gsz); u.pn = (wgid % nig) / gsz; u.pk = 0; u.nt = nt; u.koff = 0; u.kind = 0; return true;
    }
    __device__ __forceinline__ void a_ready(const Unit&) const {}
    __device__ __forceinline__ void done(const Unit&) const {}
};
template <class Epi, class Sched, bool ALIGN_EPI = false, bool SP2 = false>
__device__ __forceinline__ void gemm_phase(PG8_LAS unsigned char* lds, const Gemm g, const Sched& S, const Epi& E) {
    const int tid = threadIdx.x, wid = __builtin_amdgcn_readfirstlane(tid >> 6), lane = tid & 63, wr = wid >> 2, wc = wid & 3, fr = lane & 15, fq = lane >> 4;
    const int K = g.K;
    unsigned voffA[2], voffB[2];
#pragma unroll
    for (int i = 0; i < 2; ++i) { int R, C; stage_rc(tid * 16 + i * 8192, R, C); const int Rb = Epi::PERM ? ((R & ~31) + perm32(R & 31)) : R;
        voffA[i] = (unsigned)(R * K + C) * 2u; voffB[i] = (unsigned)(Rb * K + C) * 2u; }
    const size_t kstep = (size_t)(BK * 2);
    const size_t hstep = (size_t)HALF * K * 2;
    const size_t tstep = 2 * hstep;
    const unsigned ldsw = (unsigned)wid * 1024u;
    const int aoff = lds_byte(wr * 64 + fr, fq * 8), boff = lds_byte(wc * 32 + fr, fq * 8);
#define PG8_SA(b, h) (((b) * 2 + (h)) * HTB)
#define PG8_SB(b, h) ((4 + (b) * 2 + (h)) * HTB)
#define PG8_STAGE(bufoff, gbase, voff) do { _Pragma("unroll") for (int _i = 0; _i < 2; ++_i) \
        __builtin_amdgcn_global_load_lds((const unsigned*)((const char*)(gbase) + (voff)[_i]), (PG8_LAS unsigned*)(lds + (bufoff) + ldsw + _i * 8192), 16, 0, 0); } while (0)
#define PG8_LDA(dst, b, h) do { _Pragma("unroll") for (int m = 0; m < 4; ++m) _Pragma("unroll") for (int k = 0; k < 2; ++k) dst[m][k] = *(const PG8_LAS bf16x8*)(lds + PG8_SA(b, h) + aoff + m * 2048 + k * 1024); } while (0)
#define PG8_LDB(dst, b, h) do { _Pragma("unroll") for (int n = 0; n < 2; ++n) _Pragma("unroll") for (int k = 0; k < 2; ++k) dst[n][k] = *(const PG8_LAS bf16x8*)(lds + PG8_SB(b, h) + boff + n * 2048 + k * 1024); } while (0)
#define PG8_MMA(ai, bj, At, Bt) do { __builtin_amdgcn_s_setprio(1); _Pragma("unroll") for (int m = 0; m < 4; ++m) _Pragma("unroll") for (int n = 0; n < 2; ++n) _Pragma("unroll") for (int k = 0; k < 2; ++k) \
        acc[ai][bj][m][n] = __builtin_amdgcn_mfma_f32_16x16x32_bf16(Bt[n][k], At[m][k], acc[ai][bj][m][n], 0, 0, 0); __builtin_amdgcn_s_setprio(0); } while (0)
#define PG8_WAIT_V(n) asm volatile("s_waitcnt vmcnt(" #n ")" ::: "memory")
#define PG8_WAIT_L(n) asm volatile("s_waitcnt lgkmcnt(" #n ")" ::: "memory")
#define PG8_BAR __builtin_amdgcn_s_barrier()
#define PG8_SCHED __builtin_amdgcn_sched_barrier(0)
    Unit cur, nxt; int ui = 0;
    if (!S.next(0, cur)) return;
    int nt = cur.nt;
    f32x4 acc[2][2][4][2];
#pragma unroll
    for (int a = 0; a < 2; ++a)
#pragma unroll
        for (int b = 0; b < 2; ++b)
#pragma unroll
            for (int m = 0; m < 4; ++m)
#pragma unroll
                for (int n = 0; n < 2; ++n) acc[a][b][m][n] = (f32x4){0.f, 0.f, 0.f, 0.f};
    bf16x8 At[4][2], B0[2][2], B1[2][2];
    const char* cA = (const char*)(cur.kind ? g.A2 : g.A) + (size_t)cur.pm * tstep + (size_t)cur.koff * kstep; const char* cB = (const char*)(cur.kind ? g.Bt2 : g.Bt) + (size_t)cur.pn * tstep + (size_t)cur.koff * kstep;
    S.a_ready(cur);
    if constexpr (SP2) {
        PG8_STAGE(PG8_SB(0, 0), cB, voffB); PG8_STAGE(PG8_SB(0, 1), cB + hstep, voffB); PG8_STAGE(PG8_SA(0, 0), cA, voffA); PG8_STAGE(PG8_SA(0, 1), cA + hstep, voffA);
        if (wr == 1) PG8_BAR;
        PG8_WAIT_V(2); PG8_BAR;
        PG8_STAGE(PG8_SB(1, 0), cB + kstep, voffB); PG8_STAGE(PG8_SA(1, 0), cA + kstep, voffA); PG8_STAGE(PG8_SB(1, 1), cB + hstep + kstep, voffB);
        PG8_WAIT_V(6); PG8_BAR;
    } else {
        PG8_STAGE(PG8_SB(0, 0), cB, voffB); PG8_STAGE(PG8_SA(0, 0), cA, voffA); PG8_STAGE(PG8_SB(0, 1), cB + hstep, voffB); PG8_STAGE(PG8_SA(0, 1), cA + hstep, voffA);
        if (wr == 1) PG8_BAR;
        PG8_WAIT_V(4); PG8_BAR;
        PG8_STAGE(PG8_SB(1, 0), cB + kstep, voffB); PG8_STAGE(PG8_SA(1, 0), cA + kstep, voffA); PG8_STAGE(PG8_SB(1, 1), cB + hstep + kstep, voffB);
        PG8_WAIT_V(6); PG8_BAR;
    }
    for (;;) {
        const bool has_next = S.next(ui + 1, nxt);
        const char* nA = has_next ? (const char*)(nxt.kind ? g.A2 : g.A) + (size_t)nxt.pm * tstep + (size_t)nxt.koff * kstep : cA; const char* nB = has_next ? (const char*)(nxt.kind ? g.Bt2 : g.Bt) + (size_t)nxt.pn * tstep + (size_t)nxt.koff * kstep : cB;
        for (int t = 0; t < nt; t += 2) {
            const bool last = (t == nt - 2);
            const char* a1 = cA + (size_t)(t + 1) * kstep;
            const char* a2 = last ? nA : cA + (size_t)(t + 2) * kstep; const char* b2 = last ? nB : cB + (size_t)(t + 2) * kstep;
            const char* a3 = a2 + kstep; const char* b3 = b2 + kstep;
            if (last && has_next) S.a_ready(nxt);
            if constexpr (SP2) {
            PG8_LDB(B0, 0, 0); PG8_LDB(B1, 0, 1); PG8_SCHED; PG8_LDA(At, 0, 0); PG8_STAGE(PG8_SA(1, 1), a1 + hstep, voffA);
            PG8_WAIT_V(8); PG8_WAIT_L(0); PG8_BAR; PG8_MMA(0, 0, At, B0); PG8_MMA(0, 1, At, B1); PG8_BAR; PG8_SCHED;
            PG8_LDA(At, 0, 1); PG8_STAGE(PG8_SB(0, 0), b2, voffB); PG8_STAGE(PG8_SB(0, 1), b2 + hstep, voffB); PG8_STAGE(PG8_SA(0, 0), a2, voffA);
            PG8_WAIT_V(8); PG8_WAIT_L(0); PG8_BAR; PG8_MMA(1, 0, At, B0); PG8_MMA(1, 1, At, B1); PG8_BAR; PG8_SCHED;
            PG8_LDB(B0, 1, 0); PG8_LDB(B1, 1, 1); PG8_SCHED; PG8_LDA(At, 1, 0); PG8_STAGE(PG8_SA(0, 1), a2 + hstep, voffA);
            PG8_WAIT_V(8); PG8_WAIT_L(0); PG8_BAR; PG8_MMA(0, 0, At, B0); PG8_MMA(0, 1, At, B1); PG8_BAR; PG8_SCHED;
            PG8_LDA(At, 1, 1); PG8_STAGE(PG8_SB(1, 0), b3, voffB); PG8_STAGE(PG8_SB(1, 1), b3 + hstep, voffB); PG8_STAGE(PG8_SA(1, 0), a3, voffA);
            PG8_WAIT_V(8); PG8_WAIT_L(0); PG8_BAR; PG8_MMA(1, 0, At, B0); PG8_MMA(1, 1, At, B1); PG8_BAR; PG8_SCHED;
            } else {
            PG8_LDB(B0, 0, 0); PG8_SCHED; PG8_LDA(At, 0, 0); PG8_STAGE(PG8_SA(1, 1), a1 + hstep, voffA);
            PG8_WAIT_L(8); PG8_BAR; PG8_WAIT_L(0); PG8_MMA(0, 0, At, B0); PG8_BAR; PG8_SCHED;
            PG8_LDB(B1, 0, 1); PG8_STAGE(PG8_SB(0, 0), b2, voffB);
            PG8_BAR; PG8_WAIT_L(0); PG8_MMA(0, 1, At, B1); PG8_BAR;
            PG8_LDA(At, 0, 1); PG8_STAGE(PG8_SA(0, 0), a2, voffA);
            PG8_BAR; PG8_WAIT_L(0); PG8_MMA(1, 0, At, B0); PG8_BAR; PG8_SCHED;
            PG8_STAGE(PG8_SB(0, 1), b2 + hstep, voffB);
            PG8_WAIT_V(6); PG8_BAR; PG8_MMA(1, 1, At, B1); PG8_BAR;
            PG8_LDB(B0, 1, 0); PG8_SCHED; PG8_LDA(At, 1, 0); PG8_STAGE(PG8_SA(0, 1), a2 + hstep, voffA);
            PG8_WAIT_L(8); PG8_BAR; PG8_WAIT_L(0); PG8_MMA(0, 0, At, B0); PG8_BAR; PG8_SCHED;
            PG8_LDB(B1, 1, 1); PG8_STAGE(PG8_SB(1, 0), b3, voffB);
            PG8_BAR; PG8_WAIT_L(0); PG8_MMA(0, 1, At, B1); PG8_BAR;
            PG8_LDA(At, 1, 1); PG8_STAGE(PG8_SA(1, 0), a3, voffA);
            PG8_BAR; PG8_WAIT_L(0); PG8_MMA(1, 0, At, B0); PG8_BAR; PG8_SCHED;
            PG8_STAGE(PG8_SB(1, 1), b3 + hstep, voffB);
            PG8_WAIT_V(6); PG8_BAR; PG8_MMA(1, 1, At, B1); PG8_BAR;
            }
        }
        if constexpr (ALIGN_EPI) { if (wr == 0) PG8_BAR; }
        bool keep = false;
        if constexpr (!Epi::AFTER_DRAIN) { keep = E(acc, cur, wr, wc, fr, fq); S.done(cur); }
        if (!has_next) break;
        if (!keep)
        {
#pragma unroll
        for (int a = 0; a < 2; ++a)
#pragma unroll
            for (int b = 0; b < 2; ++b)
#pragma unroll
                for (int m = 0; m < 4; ++m)
#pragma unroll
                    for (int n = 0; n < 2; ++n) acc[a][b][m][n] = (f32x4){0.f, 0.f, 0.f, 0.f};
        }
        cur = nxt; cA = nA; cB = nB; ++ui; nt = cur.nt;
        if constexpr (ALIGN_EPI) { if (wr == 1) PG8_BAR; }
    }
    PG8_WAIT_V(0);
    if constexpr (!ALIGN_EPI) { if (wr == 0) PG8_BAR; }
    PG8_BAR;
    if constexpr (Epi::AFTER_DRAIN) { E.fused(acc, cur, wr, wc, fr, fq, lds, wid, lane); S.done(cur); }
#undef PG8_SA
#undef PG8_SB
#undef PG8_STAGE
#undef PG8_LDA
#undef PG8_LDB
#undef PG8_MMA
#undef PG8_WAIT_V
#undef PG8_WAIT_L
#undef PG8_BAR
#undef PG8_SCHED
}
}

using pg8::bf16_t; using pg8::bf16x8; using pg8::f32x4; using pg8::u32x4;
#define LAS __attribute__((address_space(3)))
typedef float f32x2 __attribute__((ext_vector_type(2)));
typedef unsigned u32x2 __attribute__((ext_vector_type(2)));
typedef __bf16 bf16x2_t __attribute__((ext_vector_type(2)));

constexpr int DM = 2048, AW = 1024, KVW = 256, INC = 6656, DFF = 8192;
constexpr int M2 = 9216, M1 = 9232, MP = 9472;
constexpr int PAST = 16384;
constexpr size_t O_Y = 0, O_KP = 18874368, O_VP = 18907136, O_SRP = 18939904, O_SIP = 18944000, O_KS = 18948096, O_VS = 23142400, O_SRS = 27336704, O_SIS = 27860992;
constexpr size_t WS_AB = 0;
constexpr size_t WS_BB = 32768;
constexpr size_t WS_E = WS_BB + 524288;
constexpr size_t WS_BAR = 8388608 - 65536;
constexpr size_t WS_WIN = 8388608;
constexpr size_t WS_WGLU = WS_WIN + (size_t)INC * DM * 2;
constexpr size_t WS_WA = WS_WGLU + (size_t)1024 * 1024 * 2;
constexpr size_t WS_WS = WS_WA + (size_t)2048 * 1024 * 2;
constexpr size_t WS_WOUT = WS_WS + (size_t)2048 * 1024 * 2;
constexpr size_t WS_WUP = WS_WOUT + (size_t)2048 * 2048 * 2;
constexpr size_t WS_WDN = WS_WUP + (size_t)DFF * DM * 2;
constexpr size_t WS_H = WS_WDN + (size_t)DFF * DM * 2;
constexpr size_t WS_R = WS_H + (size_t)MP * DM * 2;
constexpr size_t WS_Q = WS_R;
constexpr size_t WS_K = WS_Q + (size_t)MP * 1024 * 2;
constexpr size_t WS_V = WS_K + (size_t)MP * 256 * 2;
constexpr size_t WS_U = WS_V + (size_t)MP * 256 * 2;
constexpr size_t WS_G = WS_U + (size_t)MP * 1024 * 4;
constexpr size_t WS_Z = WS_G + (size_t)MP * 4096 * 2;
constexpr size_t WS_END = WS_Z + (size_t)MP * 1024 * 2;
constexpr size_t WS_ACT = WS_R;
static_assert(WS_ACT + (size_t)M2 * DFF * 2 <= WS_END, "act overlay");
static_assert(WS_E + (size_t)129 * 4096 * 8 <= WS_BAR, "ssm scratch");

#ifndef GS_AT_START
#define GS_AT_START 1
#endif
constexpr int UP_P0 = 1536, UP_P5 = 1536, DN_P5 = 1536;
constexpr int DN_P0 = 0;
#ifndef EPI_SB
#define EPI_SB 0
#endif
#ifndef PROBE
#define PROBE 0
#endif
constexpr int LDS_BYTES = 135168;

struct Params { const float* in[27]; float* out; unsigned char* ws; };

__device__ __forceinline__ unsigned pk2(float lo, float hi) { f32x2 v = {lo, hi}; bf16x2_t b = __builtin_convertvector(v, bf16x2_t); return __builtin_bit_cast(unsigned, b); }
__device__ __forceinline__ u32x4 pk8(f32x4 a, f32x4 b) { u32x4 w; w.x = pk2(a[0], a[1]); w.y = pk2(a[2], a[3]); w.z = pk2(b[0], b[1]); w.w = pk2(b[2], b[3]); return w; }
__device__ __forceinline__ float bf_lo(unsigned w) { return __builtin_bit_cast(float, w << 16); }
__device__ __forceinline__ float bf_hi(unsigned w) { return __builtin_bit_cast(float, w & 0xffff0000u); }
__device__ __forceinline__ void unpk8(u32x4 w, f32x4& a, f32x4& b) { a = (f32x4){bf_lo(w.x), bf_hi(w.x), bf_lo(w.y), bf_hi(w.y)}; b = (f32x4){bf_lo(w.z), bf_hi(w.z), bf_lo(w.w), bf_hi(w.w)}; }
__device__ __forceinline__ float sigmoidf_(float x) { return __builtin_amdgcn_rcpf(1.f + __expf(-x)); }
__device__ __forceinline__ f32x4 sig4(f32x4 v) { return (f32x4){sigmoidf_(v[0]), sigmoidf_(v[1]), sigmoidf_(v[2]), sigmoidf_(v[3])}; }
__device__ __forceinline__ float gelu_tanh(float x) { const float t = 1.5957691216057308f * (x + 0.044715f * x * x * x); return x * sigmoidf_(t); }
__device__ __forceinline__ float wave_sum(float v) {
#pragma unroll
    for (int o = 1; o < 64; o <<= 1) v += __shfl_xor(v, o);
    return v;
}
#define LDS_WAIT() asm volatile("s_waitcnt lgkmcnt(0)" ::: "memory")

struct SchedRem {
    int pm0, nN, sp, nt, G, c;
    __device__ __forceinline__ bool next(int i, pg8::Unit& u) const { const int L = i * G + c; if (L >= 4 * nN * sp) return false; u.pk = L % sp; const int rt = L / sp; u.pm = pm0 + (rt & 3); u.pn = rt >> 2; u.nt = nt; u.koff = u.pk * nt; u.kind = 0; return true; }
};
struct SchedSplit {
    pg8::StaticOrder full; SchedRem rem;
    __device__ __forceinline__ bool next(int i, pg8::Unit& u) const {
        const int tot = 4 * rem.nN * rem.sp, nr = rem.c < tot ? (tot - rem.c + rem.G - 1) / rem.G : 0, nf = full.c < full.nwg ? (full.nwg - full.c + full.G - 1) / full.G : 0;
        if ((rem.c >> 3) & 1) return i < nf ? full.next(i, u) : rem.next(i - nf, u);
        return i < nr ? rem.next(i, u) : full.next(i - nr, u); }
    __device__ __forceinline__ void a_ready(const pg8::Unit&) const {}
    __device__ __forceinline__ void done(const pg8::Unit&) const {}
};
struct SchedP4 {
    int G, c;
    __device__ __forceinline__ bool next(int i, pg8::Unit& u) const {
        const int L = i * G + c; if (L >= 256) return false;
        pg8::StaticOrder so;
        if (L < 144) { so.init(M2, 1024, 1 << 28, L, 16); so.next(0, u); }
        else { so.init(14 * 256, 2048, 1 << 28, L - 144, 16); so.next(0, u); u.pm += 22; u.kind = 1; }
        return true;
    }
    __device__ __forceinline__ void a_ready(const pg8::Unit&) const {}
    __device__ __forceinline__ void done(const pg8::Unit&) const {}
};
struct SchedP5 {
    int G, c;
    __device__ __forceinline__ bool next(int i, pg8::Unit& u) const {
        const bool g256 = (G == 256); int cnt = 0;
        const int stride = g256 ? 80 : G, last = g256 ? (c < 176 ? c + 1 : 288) : 288;
        for (int it = c; it < last; it += stride) {
            const int n = it < 176 ? 2 : 1;
            if (i < cnt + n) {
                pg8::StaticOrder so;
                if (it < 176) { so.init(22 * 256, 2048, 1 << 28, it, 16); so.next(0, u); u.kind = i - cnt; }
                else { so.init(14 * 256, 2048, 1 << 28, it - 176, 16); so.next(0, u); u.pm += 22; u.kind = 2; }
                return true;
            }
            cnt += n;
        }
        return false;
    }
    __device__ __forceinline__ void a_ready(const pg8::Unit&) const {}
    __device__ __forceinline__ void done(const pg8::Unit&) const {}
};
struct NoPre {};
template <class F> struct Epi {
    static constexpr bool PERM = true, AFTER_DRAIN = false;
    F f;
    __device__ __forceinline__ bool operator()(f32x4 (&acc)[2][2][4][2], const pg8::Unit& u, int wr, int wc, int fr, int fq) const {
        const int row0 = u.pm * 256 + wr * 64 + fr, col0 = u.pn * 256 + wc * 32 + 8 * fq, kk = u.pk + 16 * u.kind;
#pragma unroll
        for (int ai = 0; ai < 2; ++ai)
#pragma unroll
            for (int mp = 0; mp < 4; mp += 2) {
                typename F::Pre p[2][2];
#pragma unroll
                for (int mi = 0; mi < 2; ++mi)
#pragma unroll
                    for (int bj = 0; bj < 2; ++bj) f.pre(row0 + ai * 128 + (mp + mi) * 16, col0 + bj * 128, kk, p[mi][bj]);
#pragma unroll
                for (int mi = 0; mi < 2; ++mi)
#pragma unroll
                    for (int bj = 0; bj < 2; ++bj) f.post(row0 + ai * 128 + (mp + mi) * 16, col0 + bj * 128, acc[ai][bj][mp + mi][0], acc[ai][bj][mp + mi][1], kk, p[mi][bj]);
            }
        return false;
    }
};
struct F1 {
    typedef NoPre Pre;
    bf16_t *Q, *Kb, *Vb, *G; float* U; float* out;
    __device__ __forceinline__ void pre(int, int, int, Pre&) const {}
    __device__ __forceinline__ void post(int row, int col, f32x4 v0, f32x4 v1, int, const Pre&) const {
        if (col < 1024) { *(u32x4*)(Q + (size_t)row * 1024 + col) = pk8(v0 * 0.125f, v1 * 0.125f); }
        else if (col < 1536) {
            const bool isv = col >= 1280; const int c = col - (isv ? 1280 : 1024);
            *(u32x4*)((isv ? Vb : Kb) + (size_t)row * 256 + c) = pk8(v0, v1);
            float* o = nullptr;
            if (row >= 8064 && row < 8192) o = out + (isv ? O_VP : O_KP) + (size_t)(row - 8064) * 256 + c;
            else if (row >= 8192 && row < 9216) { const int b = (row - 8192) >> 3, i = (row - 8192) & 7; o = out + (isv ? O_VS : O_KS) + (size_t)(b * 128 + 120 + i) * 256 + c; }
            if (o) { *(f32x4*)o = v0; *(f32x4*)(o + 4) = v1; }
        } else if (col < 2560) { float* o = U + (size_t)row * 1024 + (col - 1536); *(f32x4*)o = v0; *(f32x4*)(o + 4) = v1; }
        else { *(u32x4*)(G + (size_t)row * 4096 + (col - 2560)) = pk8(sig4(v0), sig4(v1)); }
    }
};
struct F45 {
    struct Pre { u32x4 w; f32x4 b0, b1; };
    const bf16_t* Z; const float* bias; bf16_t* S; const bf16_t* G; float* T;
    __device__ __forceinline__ void pre(int row, int col, int kk, Pre& p) const {
        if (kk == 0) { p.w = *(const u32x4*)(Z + (size_t)row * 1024 + col); p.b0 = *(const f32x4*)(bias + col); p.b1 = *(const f32x4*)(bias + col + 4); }
        else p.w = *(const u32x4*)(G + (size_t)row * 4096 + col);
    }
    __device__ __forceinline__ void post(int row, int col, f32x4 v0, f32x4 v1, int kk, const Pre& p) const {
        f32x4 a, b; unpk8(p.w, a, b);
        if (kk == 0) *(u32x4*)(S + (size_t)row * 1024 + col) = pk8(a * sig4(v0 + p.b0), b * sig4(v1 + p.b1));
        else { float* o = T + (size_t)row * 2048 + col; *(f32x4*)o = a * v0; *(f32x4*)(o + 4) = b * v1; }
    }
};
struct EpiP5 {
    static constexpr bool PERM = true, AFTER_DRAIN = false;
    const bf16_t* G; const float* T; bf16_t* Mg;
    __device__ __forceinline__ bool operator()(f32x4 (&acc)[2][2][4][2], const pg8::Unit& u, int wr, int wc, int fr, int fq) const {
        const int row0 = u.pm * 256 + wr * 64 + fr, col0 = u.pn * 256 + wc * 32 + 8 * fq;
        const f32x4 tiny = {1e-20f, 1e-20f, 1e-20f, 1e-20f};
#pragma unroll
        for (int ai = 0; ai < 2; ++ai)
#pragma unroll
            for (int mp = 0; mp < 4; ++mp) {
                u32x4 gs[1][2], ga[1][2]; f32x4 t0[1][2], t1[1][2];
#pragma unroll
                for (int mi = 0; mi < 1; ++mi)
#pragma unroll
                    for (int bj = 0; bj < 2; ++bj) {
                        const int row = row0 + ai * 128 + (mp + mi) * 16, col = col0 + bj * 128;
                        gs[mi][bj] = *(const u32x4*)(G + (size_t)row * 4096 + 2048 + col);
                        if (u.kind == 0) ga[mi][bj] = *(const u32x4*)(G + (size_t)row * 4096 + col);
                        if (u.kind == 2) { const float* t = T + (size_t)row * 2048 + col; t0[mi][bj] = *(const f32x4*)t; t1[mi][bj] = *(const f32x4*)(t + 4); }
                    }
#pragma unroll
                for (int mi = 0; mi < 1; ++mi)
#pragma unroll
                    for (int bj = 0; bj < 2; ++bj) {
                        const int row = row0 + ai * 128 + (mp + mi) * 16, col = col0 + bj * 128;
                        f32x4 s0, s1; unpk8(gs[mi][bj], s0, s1);
                        f32x4& v0 = acc[ai][bj][mp + mi][0]; f32x4& v1 = acc[ai][bj][mp + mi][1];
                        if (u.kind == 0) {
                            f32x4 a0, a1; unpk8(ga[mi][bj], a0, a1);
                            s0 = __builtin_elementwise_max(s0, tiny); s1 = __builtin_elementwise_max(s1, tiny);
                            v0 = v0 * (a0 / s0); v1 = v1 * (a1 / s1);
                        } else if (u.kind == 1) {
                            s0 = __builtin_elementwise_max(s0, tiny); s1 = __builtin_elementwise_max(s1, tiny);
                            *(u32x4*)(Mg + (size_t)row * 2048 + col) = pk8(v0 * s0, v1 * s1);
                        } else {
                            *(u32x4*)(Mg + (size_t)row * 2048 + col) = pk8(t0[mi][bj] + s0 * v0, t1[mi][bj] + s1 * v1);
                        }
                    }
            }
        return u.kind == 0;
    }
};
struct F6 {
    struct Pre { f32x4 x0, x1; };
    const float *xp, *xs; float* X; float* PART;
    __device__ __forceinline__ void pre(int row, int col, int pk, Pre& p) const {
        if (!pk) { const float* x = (row < 8192 ? xp + (size_t)row * 2048 : xs + (size_t)(row - 8192) * 2048) + col; p.x0 = *(const f32x4*)x; p.x1 = *(const f32x4*)(x + 4); }
    }
    __device__ __forceinline__ void post(int row, int col, f32x4 v0, f32x4 v1, int pk, const Pre& p) const {
        if (pk) { *(u32x4*)((bf16_t*)PART + ((size_t)(pk - 1) * 1024 + (row - 8192)) * 2048 + col) = pk8(v0, v1); return; }
        float* o = X + (size_t)row * 2048 + col; *(f32x4*)o = p.x0 + v0; *(f32x4*)(o + 4) = p.x1 + v1;
    }
};
struct F8 {
    typedef NoPre Pre;
    bf16_t* ACT;
    __device__ __forceinline__ void pre(int, int, int, Pre&) const {}
    __device__ __forceinline__ void post(int row, int col, f32x4 v0, f32x4 v1, int, const Pre&) const {
        const f32x4 z = {0.f, 0.f, 0.f, 0.f}; f32x4 a = __builtin_elementwise_max(v0, z), b = __builtin_elementwise_max(v1, z);
        *(u32x4*)(ACT + (size_t)row * DFF + col) = pk8(a * a, b * b);
    }
};
struct F9 {
    struct Pre { f32x4 x0, x1; };
    float* X; float* PART;
    __device__ __forceinline__ void pre(int row, int col, int pk, Pre& p) const {
        if (!pk) { const float* o = X + (size_t)row * 2048 + col; p.x0 = *(const f32x4*)o; p.x1 = *(const f32x4*)(o + 4); }
    }
    __device__ __forceinline__ void post(int row, int col, f32x4 v0, f32x4 v1, int pk, const Pre& p) const {
        if (pk) { *(u32x4*)((bf16_t*)PART + ((size_t)(pk - 1) * 1024 + (row - 8192)) * 2048 + col) = pk8(v0, v1); return; }
        float* o = X + (size_t)row * 2048 + col; *(f32x4*)o = p.x0 + v0; *(f32x4*)(o + 4) = p.x1 + v1;
    }
};

__device__ __forceinline__ void transpose_item(const float* __restrict__ W, int K, int N, bf16_t* WT, LAS float* scr, int item, int lane) {
    const int nblk = N / 32, kb = item / nblk, nb = item % nblk, k0 = 64 * kb, n0 = 32 * nb;
    float wv[32];
#pragma unroll
    for (int i = 0; i < 32; ++i) wv[i] = W[(size_t)(k0 + 2 * i + (lane >> 5)) * N + n0 + (lane & 31)];
#pragma unroll
    for (int i = 0; i < 32; ++i) scr[(2 * i + (lane >> 5)) * 33 + (lane & 31)] = wv[i];
    LDS_WAIT();
    const int c = lane & 7;
#pragma unroll
    for (int j = 0; j < 4; ++j) { const int n = (lane >> 3) + 8 * j; const LAS float* s = scr + (8 * c) * 33 + n;
        u32x4 o; o.x = pk2(s[0 * 33], s[1 * 33]); o.y = pk2(s[2 * 33], s[3 * 33]); o.z = pk2(s[4 * 33], s[5 * 33]); o.w = pk2(s[6 * 33], s[7 * 33]);
        *(u32x4*)(WT + (size_t)(n0 + n) * K + k0 + 8 * c) = o; }
    LDS_WAIT();
}
__device__ __forceinline__ void convert_tail(const float* __restrict__ W, int K, int N, bf16_t* WT, int item0, int nitems, int ntiles, int G, int bx, int wave, int lane, LAS float* scr) {
    const int maxu = (ntiles + G - 1) / G, first_idle = ntiles - (maxu - 1) * G, nidle = G - first_idle;
    if (nidle >= 32) { if (bx >= first_idle) for (int it = item0 + (bx - first_idle) * 8 + wave; it < nitems; it += nidle * 8) transpose_item(W, K, N, WT, scr, it, lane); }
    else for (int it = item0 + bx * 8 + wave; it < nitems; it += G * 8) transpose_item(W, K, N, WT, scr, it, lane);
}
__device__ __forceinline__ void rms_row(const float* xrow, const float* __restrict__ g, bf16_t* ob, float* of, int lane, const float* part = nullptr, float* xw = nullptr) {
    f32x4 v[8]; float s = 0.f;
#pragma unroll
    for (int j = 0; j < 8; ++j) { v[j] = ((const f32x4*)xrow)[64 * j + lane];
        if (part) {
#pragma unroll
            for (int q = 0; q < 7; ++q) { const u32x2 w = ((const u32x2*)((const bf16_t*)part + (size_t)q * 1024 * 2048))[64 * j + lane]; v[j] += (f32x4){bf_lo(w.x), bf_hi(w.x), bf_lo(w.y), bf_hi(w.y)}; }
            if (xw) ((f32x4*)xw)[64 * j + lane] = v[j]; }
        s += (v[j][0] * v[j][0] + v[j][1] * v[j][1]) + (v[j][2] * v[j][2] + v[j][3] * v[j][3]); }
    const float rstd = 1.f / sqrtf(wave_sum(s) * (1.f / 2048.f) + 1e-5f);
#pragma unroll
    for (int j = 0; j < 8; ++j) { const f32x4 gg = ((const f32x4*)g)[64 * j + lane]; const f32x4 y = v[j] * rstd * gg;
        if (ob) ((u32x2*)ob)[64 * j + lane] = (u32x2){pk2(y[0], y[1]), pk2(y[2], y[3])}; else ((f32x4*)of)[64 * j + lane] = y; }
}

constexpr int KS_PITCH = 144, VT_PITCH = 424, LDS_VT_OFF = 192 * KS_PITCH;
__device__ __forceinline__ void attn_unit(const Params& P, int unit, LAS unsigned char* lds, int tid, int wave, int lane, bool dry) {
    bf16_t* Qb = (bf16_t*)(P.ws + WS_Q); const bf16_t* Kb = (const bf16_t*)(P.ws + WS_K); const bf16_t* Vb = (const bf16_t*)(P.ws + WS_V);
    const int ui = unit >> 8, ub = unit & 255, ur = (ui >> 1) * 256 + ub; const bool sample = ((ui + ub) & 1); const int kvh = ur & 3, blk = ur >> 2;
    LAS unsigned char* Ks = lds; LAS unsigned char* Vt = lds + LDS_VT_OFF;
    const int ntask = sample ? 4 : 16, r16 = lane & 15, quad = lane >> 4;
    bf16x8 qf[2][2];
#pragma unroll
    for (int j = 0; j < 2; ++j) {
        const int task = wave + 8 * j;
        if (task < ntask) {
            const int qrow = sample ? (8192 + 8 * blk + (r16 & 7)) : (64 * blk + 16 * (task >> 2) + r16);
            const bf16_t* qq = Qb + (size_t)qrow * 1024 + (kvh * 4 + (task & 3)) * 64;
            qf[j][0] = *(const bf16x8*)(qq + quad * 8); qf[j][1] = *(const bf16x8*)(qq + 32 + quad * 8);
        }
    }
    for (int idx = tid; idx < 192 * 8; idx += 512) {
        const int key = idx >> 3, ch = idx & 7;
        u32x4 kv = {0u, 0u, 0u, 0u}, vv = {0u, 0u, 0u, 0u};
        if (!sample) {
            const int pos = 64 * blk - 112 + key;
            if (pos >= 0) { const int row = pos < 16 ? 9216 + pos : pos - 16; kv = *(const u32x4*)(Kb + (size_t)row * 256 + kvh * 64 + ch * 8); vv = *(const u32x4*)(Vb + (size_t)row * 256 + kvh * 64 + ch * 8); }
        } else if (key < 128) {
            const size_t o = ((size_t)(blk * 128 + key) * 4 + kvh) * 64 + ch * 8;
            const float* pk = P.in[2] + o; const float* pv = P.in[3] + o;
            kv = pk8(*(const f32x4*)pk, *(const f32x4*)(pk + 4)); vv = pk8(*(const f32x4*)pv, *(const f32x4*)(pv + 4));
        } else if (key < 136) {
            const int row = 8192 + 8 * blk + key - 128; kv = *(const u32x4*)(Kb + (size_t)row * 256 + kvh * 64 + ch * 8); vv = *(const u32x4*)(Vb + (size_t)row * 256 + kvh * 64 + ch * 8);
        }
        *(LAS u32x4*)(Ks + key * KS_PITCH + ch * 16) = kv;
        LAS unsigned short* vt = (LAS unsigned short*)(Vt + (ch * 8) * VT_PITCH + key * 2);
        vt[0 * (VT_PITCH / 2)] = (unsigned short)(vv.x & 0xffffu); vt[1 * (VT_PITCH / 2)] = (unsigned short)(vv.x >> 16);
        vt[2 * (VT_PITCH / 2)] = (unsigned short)(vv.y & 0xffffu); vt[3 * (VT_PITCH / 2)] = (unsigned short)(vv.y >> 16);
        vt[4 * (VT_PITCH / 2)] = (unsigned short)(vv.z & 0xffffu); vt[5 * (VT_PITCH / 2)] = (unsigned short)(vv.z >> 16);
        vt[6 * (VT_PITCH / 2)] = (unsigned short)(vv.w & 0xffffu); vt[7 * (VT_PITCH / 2)] = (unsigned short)(vv.w >> 16);
    }
    for (int idx = tid; idx < 64 * 20; idx += 512) { const int d = idx / 20, k = 192 + idx % 20; *(LAS unsigned short*)(Vt + d * VT_PITCH + k * 2) = 0; }
    __syncthreads();
#pragma unroll 1
    for (int j = 0; j < 2; ++j) {
        const int task = wave + 8 * j; if (task >= ntask) break;
        const int head = kvh * 4 + (task & 3), tql = 16 * (task >> 2);
        const int qrow = sample ? (8192 + 8 * blk + (r16 & 7)) : (64 * blk + tql + r16);
        bf16_t* qp = Qb + (size_t)qrow * 1024 + head * 64;
        const bf16x8 q0 = j ? qf[1][0] : qf[0][0], q1 = j ? qf[1][1] : qf[0][1];
        const float slope = exp2f(-0.5f * (float)(head + 1)), sink = P.in[9][head];
        float s[10][4]; float mx = -1e30f;
#pragma unroll
        for (int kb = 0; kb < 9; ++kb) {
            const LAS unsigned char* kp = Ks + (tql + kb * 16 + r16) * KS_PITCH + quad * 16;
            const bf16x8 a0 = *(const LAS bf16x8*)kp, a1 = *(const LAS bf16x8*)(kp + 64);
            f32x4 acc = {0.f, 0.f, 0.f, 0.f};
            acc = __builtin_amdgcn_mfma_f32_16x16x32_bf16(a0, q0, acc, 0, 0, 0);
            acc = __builtin_amdgcn_mfma_f32_16x16x32_bf16(a1, q1, acc, 0, 0, 0);
#pragma unroll
            for (int i = 0; i < 4; ++i) {
                const int kin = kb * 16 + quad * 4 + i, kl = tql + kin, dist = 128 + r16 - kin;
                const bool kvalid = sample ? (kl < 136) : (64 * blk - 112 + kl >= 0);
                const bool valid = dist >= 0 && dist <= 128 && kvalid;
                const float sv = valid ? acc[i] - slope * (float)dist : -1e30f;
                s[kb][i] = sv; mx = fmaxf(mx, sv);
            }
        }
        mx = fmaxf(mx, __shfl_xor(mx, 16)); mx = fmaxf(mx, __shfl_xor(mx, 32)); mx = fmaxf(mx, sink);
        float sum = 0.f;
#pragma unroll
        for (int kb = 0; kb < 9; ++kb)
#pragma unroll
            for (int i = 0; i < 4; ++i) { const float p = __expf(s[kb][i] - mx); s[kb][i] = p; sum += p; }
#pragma unroll
        for (int i = 0; i < 4; ++i) s[9][i] = 0.f;
        sum += __shfl_xor(sum, 16); sum += __shfl_xor(sum, 32);
        const float inv = 1.f / (sum + __expf(sink - mx));
        f32x4 o[4];
#pragma unroll
        for (int db = 0; db < 4; ++db) o[db] = (f32x4){0.f, 0.f, 0.f, 0.f};
#pragma unroll
        for (int pp = 0; pp < 5; ++pp) {
            u32x4 pw; pw.x = pk2(s[2 * pp][0], s[2 * pp][1]); pw.y = pk2(s[2 * pp][2], s[2 * pp][3]); pw.z = pk2(s[2 * pp + 1][0], s[2 * pp + 1][1]); pw.w = pk2(s[2 * pp + 1][2], s[2 * pp + 1][3]);
            const bf16x8 pb = __builtin_bit_cast(bf16x8, pw);
#pragma unroll
            for (int db = 0; db < 4; ++db) {
                const LAS unsigned char* vp = Vt + (db * 16 + r16) * VT_PITCH + (tql + pp * 32 + quad * 4) * 2;
                const u32x2 lo = *(const LAS u32x2*)vp, hi = *(const LAS u32x2*)(vp + 32);
                const u32x4 vw = {lo.x, lo.y, hi.x, hi.y};
                o[db] = __builtin_amdgcn_mfma_f32_16x16x32_bf16(__builtin_bit_cast(bf16x8, vw), pb, o[db], 0, 0, 0);
            }
        }
        if ((!sample || r16 < 8) && !dry) {
#pragma unroll
            for (int db = 0; db < 4; ++db) { const f32x4 v = o[db] * inv; *(u32x2*)(qp + db * 16 + quad * 4) = (u32x2){pk2(v[0], v[1]), pk2(v[2], v[3])}; }
        }
    }
    __syncthreads();
}

constexpr int BU_PITCH = 528, HS_PITCH = 272, SSM_WL = 16 * BU_PITCH + 16 * HS_PITCH;
struct SsmM { float ar, ai; bf16x8 bf[8]; };
__device__ __forceinline__ void ssm_load_m(const Params& P, int g, int lane, SsmM& C) {
    const f32x2 ab = ((const f32x2*)(P.ws + WS_AB))[g * 64 + lane]; C.ar = ab[0]; C.ai = ab[1];
    const int r16 = lane & 15, quad = lane >> 4, c0 = (quad & 1) * 8;
    const f32x2* bb = (const f32x2*)(P.ws + WS_BB) + (size_t)g * 16 * 64;
#pragma unroll
    for (int blk = 0; blk < 8; ++blk) {
        const int p = (16 * blk + r16) & 63; float v[8];
#pragma unroll
        for (int j = 0; j < 8; ++j) { const f32x2 e = bb[(c0 + j) * 64 + p]; v[j] = blk >= 4 ? e[1] : e[0]; }
        C.bf[blk] = __builtin_bit_cast(bf16x8, pk8((f32x4){v[0], v[1], v[2], v[3]}, (f32x4){v[4], v[5], v[6], v[7]}));
    }
}
struct URaw { f32x4 a[4], b[4]; };
__device__ __forceinline__ void ssm_fetch_raw(const Params& P, int row0, int L, int g, int lane, URaw& u) {
    const float* U = (const float*)(P.ws + WS_U); const int r16 = lane & 15, quad = lane >> 4;
#pragma unroll
    for (int sb = 0; sb < 4; ++sb) {
        const int tok = sb * 16 + r16;
        if (tok < L) { const float* src = U + (size_t)(row0 + tok) * 1024 + g * 16 + (quad & 1) * 8; u.a[sb] = *(const f32x4*)src; u.b[sb] = *(const f32x4*)(src + 4); }
        else { u.a[sb] = (f32x4){0.f, 0.f, 0.f, 0.f}; u.b[sb] = (f32x4){0.f, 0.f, 0.f, 0.f}; }
    }
}
__device__ __forceinline__ void ssm_bu_block(const SsmM& C, f32x4 a, f32x4 b, LAS unsigned char* BU, int r16, int quad) {
    const u32x4 hi = pk8(a, b); f32x4 ha, hb; unpk8(hi, ha, hb); const u32x4 lo = pk8(a - ha, b - hb);
    const bf16x8 uf = __builtin_bit_cast(bf16x8, quad >= 2 ? lo : hi);
#pragma unroll
    for (int blk = 0; blk < 8; ++blk) {
        f32x4 d = {0.f, 0.f, 0.f, 0.f}; d = __builtin_amdgcn_mfma_f32_16x16x32_bf16(C.bf[blk], uf, d, 0, 0, 0);
        *(LAS f32x4*)(BU + r16 * BU_PITCH + blk * 64 + quad * 16) = d;
    }
    LDS_WAIT();
}
__device__ __forceinline__ void ssm_rec(const SsmM& C, const LAS unsigned char* BU, int t, int lane, float& hr, float& hi) {
    const float br = *(const LAS float*)(BU + t * BU_PITCH + lane * 4), bi = *(const LAS float*)(BU + t * BU_PITCH + 256 + lane * 4);
    const float nr = fmaf(C.ar, hr, fmaf(-C.ai, hi, br)), ni = fmaf(C.ar, hi, fmaf(C.ai, hr, bi));
    hr = nr; hi = ni;
}
template <int NT> __device__ __forceinline__ void ssm_rec_block(const SsmM& C, const LAS unsigned char* BU, LAS unsigned char* Hs, int lane, float& hr, float& hi) {
#pragma unroll
    for (int t = 0; t < NT; ++t) {
        ssm_rec(C, BU, t, lane, hr, hi);
        const unsigned w = pk2(hr, hi);
        *(LAS unsigned short*)(Hs + t * HS_PITCH + lane * 2) = (unsigned short)(w & 0xffffu);
        *(LAS unsigned short*)(Hs + t * HS_PITCH + 128 + lane * 2) = (unsigned short)(w >> 16);
    }
}
__device__ __forceinline__ void ssm_passA(const Params& P, int g, int slot, int nslots, LAS unsigned char* wl, int lane) {
    const int r16 = lane & 15, quad = lane >> 4;
    SsmM C; ssm_load_m(P, g, lane, C);
    URaw cur, nxt; int c = slot;
    if (c < 129) ssm_fetch_raw(P, c == 0 ? 9216 : 64 * (c - 1), c == 0 ? 16 : 64, g, lane, cur);
    for (; c < 129; c += nslots) {
        const int L = c == 0 ? 16 : 64, cn = c + nslots;
        if (cn < 129) ssm_fetch_raw(P, 64 * (cn - 1), 64, g, lane, nxt);
        float hr = 0.f, hi = 0.f;
#pragma unroll
        for (int sb = 0; sb < 4; ++sb) if (sb * 16 < L) {
            ssm_bu_block(C, cur.a[sb], cur.b[sb], wl, r16, quad);
#pragma unroll
            for (int t = 0; t < 16; ++t) ssm_rec(C, wl, t, lane, hr, hi);
            LDS_WAIT();
        }
        ((f32x2*)(P.ws + WS_E))[(size_t)(c * 64 + g) * 64 + lane] = (f32x2){hr, hi};
        cur = nxt;
    }
}
__device__ __forceinline__ void ssm_passB(const Params& P, int g, int slot, int nslots, LAS unsigned char* wl, int lane) {
    LAS unsigned char* Hs = wl + 16 * BU_PITCH;
    SsmM C; ssm_load_m(P, g, lane, C);
    const int r16 = lane & 15, quad = lane >> 4;
    bf16x8 cf[4];
#pragma unroll
    for (int cc = 0; cc < 4; ++cc) {
        const float* src = (cc < 2 ? P.in[15] : P.in[16]) + (size_t)(g * 16 + r16) * 64 + (cc & 1) * 32 + quad * 8;
        f32x4 a = *(const f32x4*)src, bq = *(const f32x4*)(src + 4); if (cc >= 2) { a = -a; bq = -bq; }
        cf[cc] = __builtin_bit_cast(bf16x8, pk8(a, bq));
    }
    const f32x4 dd = *(const f32x4*)(P.in[17] + g * 16 + quad * 4);
    bf16_t* Z = (bf16_t*)(P.ws + WS_Z); const float* U = (const float*)(P.ws + WS_U);
    URaw cur, nxt; int it = slot;
    if (it < 256) ssm_fetch_raw(P, it < 128 ? 64 * it : 8192 + 8 * (it - 128), it < 128 ? 64 : 8, g, lane, cur);
    for (; it < 256; it += nslots) {
        const bool sample = it >= 128; const int b = it - 128;
        const int row0 = sample ? 8192 + 8 * b : 64 * it, L = sample ? 8 : 64;
        float hr, hi;
        if (sample) { hr = P.in[4][(size_t)(b * 64 + g) * 64 + lane]; hi = P.in[5][(size_t)(b * 64 + g) * 64 + lane]; }
        else { const f32x2 e0 = ((const f32x2*)(P.ws + WS_E))[(size_t)(it * 64 + g) * 64 + lane]; hr = e0[0]; hi = e0[1]; }
        const int in = it + nslots; if (in < 256) ssm_fetch_raw(P, in < 128 ? 64 * in : 8192 + 8 * (in - 128), in < 128 ? 64 : 8, g, lane, nxt);
#pragma unroll
        for (int sb = 0; sb < 4; ++sb) if (sb * 16 < L) {
            const int tok = sb * 16 + r16;
            f32x4 u4 = {0.f, 0.f, 0.f, 0.f}; if (tok < L) u4 = *(const f32x4*)(U + (size_t)(row0 + tok) * 1024 + g * 16 + quad * 4);
            ssm_bu_block(C, cur.a[sb], cur.b[sb], wl, r16, quad);
            if (sample) ssm_rec_block<8>(C, wl, Hs, lane, hr, hi); else ssm_rec_block<16>(C, wl, Hs, lane, hr, hi);
            LDS_WAIT();
            f32x4 acc = {0.f, 0.f, 0.f, 0.f};
#pragma unroll
            for (int cc = 0; cc < 4; ++cc) { const bf16x8 hb = *(const LAS bf16x8*)(Hs + r16 * HS_PITCH + cc * 64 + quad * 16); acc = __builtin_amdgcn_mfma_f32_16x16x32_bf16(cf[cc], hb, acc, 0, 0, 0); }
            if (tok < L) {
                const f32x4 y = acc + dd * u4;
                *(u32x2*)(Z + (size_t)(row0 + tok) * 1024 + g * 16 + quad * 4) = (u32x2){pk2(gelu_tanh(y[0]), gelu_tanh(y[1])), pk2(gelu_tanh(y[2]), gelu_tanh(y[3]))};
            }
            LDS_WAIT();
        }
        if (sample) { P.out[O_SRS + (size_t)(b * 64 + g) * 64 + lane] = hr; P.out[O_SIS + (size_t)(b * 64 + g) * 64 + lane] = hi; }
        else if (it == 127) { P.out[O_SRP + g * 64 + lane] = hr; P.out[O_SIP + g * 64 + lane] = hi; }
        cur = nxt;
    }
}

#define XB_TMO      128
#define XB_XCNT(j)  (256  + 64 * (j))
#define XB_XSUB(j)  (1280 + 64 * (j))
#define XB_XGEN(j)  (2304 + 64 * (j))
#define XB_TOP      3328
#define XB_TOPGEN   3392
#define XCD_BAR_WORDS 3456
#define XB_SPIN_CAP (1u << 18)

__device__ __forceinline__ unsigned xb_ld(unsigned* p)              { return __hip_atomic_load(p, __ATOMIC_RELAXED, __HIP_MEMORY_SCOPE_AGENT); }
__device__ __forceinline__ unsigned xb_add(unsigned* p, unsigned v) { return __hip_atomic_fetch_add(p, v, __ATOMIC_RELAXED, __HIP_MEMORY_SCOPE_AGENT); }
__device__ __forceinline__ unsigned xb_xcc_id() { return (unsigned)__builtin_amdgcn_s_getreg((3 << 11) | 20) & 0xFu; }
#define XB_SPIN(cond, bar) do { unsigned _sp = 0; while (cond) { __builtin_amdgcn_s_sleep(1); \
    if ((++_sp & 255u) == 0u) { if (xb_ld(&(bar)[XB_TMO])) break; if (_sp > XB_SPIN_CAP) { atomicAdd(&(bar)[XB_TMO], 1u); break; } } } } while (0)

struct XcdBarrier {
    unsigned* bar; unsigned x;
    volatile LAS unsigned* st;
};

__device__ __forceinline__ XcdBarrier xcd_barrier_post(unsigned* bar, volatile LAS unsigned* st) {
    XcdBarrier b; b.bar = bar; b.x = xb_xcc_id(); b.st = st;
    if (threadIdx.x == 0) (void)xb_add(&bar[XB_XCNT(b.x)], 1u);
    return b;
}
__device__ __forceinline__ void xcd_barrier_complete(unsigned* bar, unsigned x, unsigned& nloc, unsigned& nx) {
    const unsigned G = gridDim.x * gridDim.y * gridDim.z;
    unsigned sum, cnt, mine, sp = 0u;
    for (;;) {
        sum = 0u; cnt = 0u; mine = 0u;
#pragma unroll
        for (unsigned j = 0; j < 16; ++j) { const unsigned c = xb_ld(&bar[XB_XCNT(j)]); sum += c; cnt += (c > 0u) ? 1u : 0u; mine = (j == x) ? c : mine; }
        if (sum == G) break;
        __builtin_amdgcn_s_sleep(1);
        if ((++sp & 255u) == 0u) { if (xb_ld(&bar[XB_TMO])) break; if (sp > XB_SPIN_CAP) { atomicAdd(&bar[XB_TMO], 1u); break; } }
    }
    nloc = mine > 0u ? mine : 1u; nx = cnt > 0u ? cnt : 1u;
}

__device__ __forceinline__ void xcd_barrier(const XcdBarrier& b) {
    asm volatile("s_waitcnt vmcnt(0)" ::: "memory");
    __syncthreads();
    if (threadIdx.x == 0) {
        unsigned* bar = b.bar;
        __builtin_amdgcn_s_waitcnt(0);
        unsigned nloc = b.st[0], nx = b.st[1];
        if (nloc == 0u) { xcd_barrier_complete(bar, b.x, nloc, nx); b.st[0] = nloc; b.st[1] = nx; }
        const unsigned old = xb_add(&bar[XB_XSUB(b.x)], 1u);
        const unsigned gen = old / nloc;
        if (old + 1u == (gen + 1u) * nloc) {
            __builtin_amdgcn_fence(__ATOMIC_RELEASE, "agent");
            asm volatile("s_waitcnt vmcnt(0)" ::: "memory");
            const unsigned og = xb_add(&bar[XB_TOP], 1u);
            const unsigned tg = og / nx;
            if (og + 1u == (tg + 1u) * nx) xb_add(&bar[XB_TOPGEN], 1u);
            else XB_SPIN(xb_ld(&bar[XB_TOPGEN]) == tg, bar);
            __builtin_amdgcn_fence(__ATOMIC_ACQUIRE, "agent");
            xb_add(&bar[XB_XGEN(b.x)], 1u);
            asm volatile("s_waitcnt vmcnt(0)" ::: "memory");
        } else {
            XB_SPIN(xb_ld(&bar[XB_XGEN(b.x)]) == gen, bar);
            __builtin_amdgcn_fence(__ATOMIC_ACQUIRE, "agent");
            asm volatile("s_waitcnt vmcnt(0)" ::: "memory");
        }
    }
    __syncthreads();
}

__global__ void __launch_bounds__(512, 2) mega_fwd(Params P) {
    extern __shared__ __attribute__((aligned(16))) unsigned char lds_raw[];
    LAS unsigned char* lds = (LAS unsigned char*)lds_raw;
    cg::grid_group grid = cg::this_grid();
    const int tid = threadIdx.x, lane = tid & 63, wave = __builtin_amdgcn_readfirstlane(tid >> 6);
    const int G = gridDim.x, bx = blockIdx.x, gw = bx * 8 + wave, NGW = G * 8;
    unsigned char* ws = P.ws; float* out = P.out;
    unsigned long long pt0 = 0, pdur = 0;
    unsigned* barw = (unsigned*)(ws + WS_BAR);
    if (bx == 0) for (int i = tid; i < XCD_BAR_WORDS; i += 512) barw[i] = 0u;
    volatile LAS unsigned* bst = (volatile LAS unsigned*)(lds + 131072);
    if (tid < 2) bst[tid] = 0u;
    __syncthreads();
    grid.sync();
    const XcdBarrier xb = xcd_barrier_post(barw, bst);
#define PSTART(k) do { if (PROBE == (k) + 1) pt0 = __builtin_amdgcn_s_memrealtime(); } while (0)
#define PEND(k) do { if (PROBE == (k) + 1) pdur = __builtin_amdgcn_s_memrealtime() - pt0; } while (0)
    bf16_t* Hb = (bf16_t*)(ws + WS_H);

    PSTART(0);
    {
        LAS float* scr = (LAS float*)(lds + wave * 16384);
        constexpr int I_IN = 32 * 208, I_GLU = 16 * 32, I_A = 16 * 64, I_S = 16 * 64, I_OUT = 32 * 64, I_UP = 32 * 256, I_DN = 128 * 64;
        for (int it = gw; it < I_IN + UP_P0; it += NGW) {
            if (it < I_IN) transpose_item(P.in[8], 2048, INC, (bf16_t*)(ws + WS_WIN), scr, it, lane);
            else transpose_item(P.in[24], 2048, DFF, (bf16_t*)(ws + WS_WUP), scr, it - I_IN, lane);
        }
        for (int m = gw; m < MP; m += NGW) {
            if (m < M1) { const float* x = m < 8192 ? P.in[0] + (size_t)m * 2048 : (m < 9216 ? P.in[1] + (size_t)(m - 8192) * 2048 : P.in[6] + (size_t)(m - 9216) * 2048);
                rms_row(x, P.in[7], Hb + (size_t)m * 2048, nullptr, lane); }
            else { for (int j = 0; j < 4; ++j) ((u32x4*)(Hb + (size_t)m * 2048))[64 * j + lane] = (u32x4){0u, 0u, 0u, 0u}; }
        }
        for (int idx = bx * 512 + tid; idx < 65536; idx += G * 512) {
            const int p = idx & 63, c = (idx >> 6) & 15, g = idx >> 10, gp = g * 64 + p;
            const float are = P.in[10][gp], aim = P.in[11][gp], dt = expf(P.in[12][g]);
            const float mag = expf(dt * are), abr = mag * cosf(dt * aim), abi = mag * sinf(dt * aim);
            const float nr = abr - 1.f, ni = abi, den = are * are + aim * aim, fr = (nr * are + ni * aim) / den, fi = (ni * are - nr * aim) / den;
            if (c == 0) ((f32x2*)(ws + WS_AB))[gp] = (f32x2){abr, abi};
            const float br = P.in[13][(size_t)gp * 16 + c], bi = P.in[14][(size_t)gp * 16 + c];
            ((f32x2*)(ws + WS_BB))[(size_t)(g * 16 + c) * 64 + p] = (f32x2){fr * br - fi * bi, fr * bi + fi * br};
        }
    }
    xcd_barrier(xb);
    PEND(0);
    PSTART(1);
    {
        pg8::Gemm g{Hb, (const bf16_t*)(ws + WS_WIN), MP, INC, 2048, nullptr, nullptr}; pg8::StaticOrder S; S.init(MP, INC, G, bx, 32);
        Epi<F1> E{F1{(bf16_t*)(ws + WS_Q), (bf16_t*)(ws + WS_K), (bf16_t*)(ws + WS_V), (bf16_t*)(ws + WS_G), (float*)(ws + WS_U), out}};
        pg8::gemm_phase<Epi<F1>, pg8::StaticOrder, true, true>(lds, g, S, E);
        convert_tail(P.in[24], 2048, DFF, (bf16_t*)(ws + WS_WUP), UP_P0, 32 * 256 - UP_P5, (MP / 256) * (INC / 256), G, bx, wave, lane, (LAS float*)(lds + wave * 16384));
    }
    xcd_barrier(xb);
    PEND(1);
    PSTART(2);
    {
        for (int u = bx; u < 1024; u += G) attn_unit(P, u, lds, tid, wave, lane, false);
        LAS unsigned char* wl = lds + wave * SSM_WL;
        if (gw < (NGW / 64) * 64) ssm_passA(P, gw & 63, gw >> 6, NGW / 64, wl, lane);
    }
    xcd_barrier(xb);
    PEND(2);
    PSTART(11);
    {
        if (bx < 64) {
            const int g = bx; const f32x2 ab = ((const f32x2*)(ws + WS_AB))[g * 64 + lane];
            float pr = ab[0], pi = ab[1];
#pragma unroll
            for (int k = 0; k < 6; ++k) { const float nr = pr * pr - pi * pi, ni = 2.f * pr * pi; pr = nr; pi = ni; }
            float qr = pr, qi = pi;
#pragma unroll
            for (int k = 0; k < 4; ++k) { const float nr = qr * qr - qi * qi, ni = 2.f * qr * qi; qr = nr; qi = ni; }
            f32x2* E = (f32x2*)(ws + WS_E) + (size_t)g * 64 + lane;
            f32x2 e[16];
#pragma unroll
            for (int k = 0; k < 16; ++k) e[k] = E[(size_t)(16 * wave + k) * 4096];
            float hr = 0.f, hi = 0.f;
#pragma unroll
            for (int k = 0; k < 16; ++k) { const float nr = fmaf(pr, hr, fmaf(-pi, hi, e[k][0])), ni = fmaf(pr, hi, fmaf(pi, hr, e[k][1])); hr = nr; hi = ni; e[k] = (f32x2){hr, hi}; }
            LAS f32x2* F = (LAS f32x2*)lds;
            F[wave * 64 + lane] = (f32x2){hr, hi};
            __syncthreads();
            float cr = 0.f, ci = 0.f;
            for (int v = 0; v < wave; ++v) { const f32x2 f = F[v * 64 + lane]; const float nr = fmaf(qr, cr, fmaf(-qi, ci, f[0])), ni = fmaf(qr, ci, fmaf(qi, cr, f[1])); cr = nr; ci = ni; }
#pragma unroll
            for (int k = 0; k < 16; ++k) {
                const float nr = pr * cr - pi * ci, ni = pr * ci + pi * cr; cr = nr; ci = ni;
                if (16 * wave + k >= 1) E[(size_t)(16 * wave + k) * 4096] = (f32x2){e[k][0] + cr, e[k][1] + ci};
            }
            __syncthreads();
        }
        {
            constexpr int J_GLU = 16 * 32, J_A = 16 * 64, J_S = 16 * 64, J_OUT = 32 * 64;
            const int b0 = G > 64 ? 64 : 0, nw = (G - b0) * 8; LAS float* scr = (LAS float*)(lds + wave * 16384);
            if (bx >= b0) for (int it = (bx - b0) * 8 + wave; it < J_GLU + J_A + J_S + J_OUT; it += nw) {
                int r = it;
                if (r < J_GLU) { transpose_item(P.in[18], 1024, 1024, (bf16_t*)(ws + WS_WGLU), scr, r, lane); continue; } r -= J_GLU;
                if (r < J_A) { transpose_item(P.in[20], 1024, 2048, (bf16_t*)(ws + WS_WA), scr, r, lane); continue; } r -= J_A;
                if (r < J_S) { transpose_item(P.in[21], 1024, 2048, (bf16_t*)(ws + WS_WS), scr, r, lane); continue; } r -= J_S;
                transpose_item(P.in[22], 2048, 2048, (bf16_t*)(ws + WS_WOUT), scr, r, lane);
            }
        }
    }
    xcd_barrier(xb);
    PEND(11);
    PSTART(3);
    {
        LAS unsigned char* wl = lds + wave * SSM_WL;
#pragma unroll 1
        for (int half = 0; half < 2; ++half) {
        if ((wave & 1) == half)
        {
            const int gt = bx * 512 + tid, NGT = G * 512; constexpr int NC = 2 * 128 * 120 * 64;
            for (int i0 = gt; i0 < NC; i0 += 5 * NGT) {
                f32x4 v[5];
#pragma unroll
                for (int q = 0; q < 5; ++q) { const int i = i0 + q * NGT; if (i < NC) { const int which = i / (128 * 120 * 64), r = i % (128 * 120 * 64), bw = r >> 6, c4 = r & 63, b = bw / 120, w = bw % 120;
                    v[q] = *(const f32x4*)(P.in[2 + which] + ((size_t)(b * 128 + w + 8)) * 256 + c4 * 4); } }
#pragma unroll
                for (int q = 0; q < 5; ++q) { const int i = i0 + q * NGT; if (i < NC) { const int which = i / (128 * 120 * 64), r = i % (128 * 120 * 64), bw = r >> 6, c4 = r & 63, b = bw / 120, w = bw % 120;
                    *(f32x4*)(out + (which ? O_VS : O_KS) + ((size_t)(b * 128 + w)) * 256 + c4 * 4) = v[q]; } }
            }
        }
        if (half == 0) {
            if (gw < (NGW / 64) * 64) ssm_passB(P, gw & 63, gw >> 6, NGW / 64, wl, lane);
        }
        }
    }
    xcd_barrier(xb);
    PEND(3);
    PSTART(4);
    {
        pg8::Gemm g{(const bf16_t*)(ws + WS_Z), (const bf16_t*)(ws + WS_WGLU), M2, 1024, 1024, (const bf16_t*)(ws + WS_Q), (const bf16_t*)(ws + WS_WA)}; SchedP4 S{G, bx};
        Epi<F45> E{F45{(const bf16_t*)(ws + WS_Z), P.in[19], (bf16_t*)(ws + WS_U), (const bf16_t*)(ws + WS_G), out + O_Y}};
        pg8::gemm_phase<Epi<F45>, SchedP4, true, true>(lds, g, S, E);
    }
    xcd_barrier(xb);
    PEND(4);
    PSTART(5);
    {
        pg8::Gemm g{(const bf16_t*)(ws + WS_Q), (const bf16_t*)(ws + WS_WA), M2, 2048, 1024, (const bf16_t*)(ws + WS_U), (const bf16_t*)(ws + WS_WS)}; SchedP5 S{G, bx};
        EpiP5 E{(const bf16_t*)(ws + WS_G), out + O_Y, Hb};
        pg8::gemm_phase<EpiP5, SchedP5, true, true>(lds, g, S, E);
        {
            const int b0 = (G == 256) ? 208 : 0, nb = G - b0; LAS float* scr = (LAS float*)(lds + wave * 16384);
            if (bx >= b0) for (int it = (bx - b0) * 8 + wave; it < UP_P5 + DN_P5; it += nb * 8) {
                if (it < UP_P5) transpose_item(P.in[24], 2048, DFF, (bf16_t*)(ws + WS_WUP), scr, 32 * 256 - UP_P5 + it, lane);
                else transpose_item(P.in[25], DFF, 2048, (bf16_t*)(ws + WS_WDN), scr, it - UP_P5, lane);
            }
        }
    }
    xcd_barrier(xb);
    PEND(5);
    PSTART(6);
    {
        Epi<F6> E{F6{P.in[0], P.in[1], out + O_Y, (float*)(ws + WS_R)}};
        pg8::Gemm g{Hb, (const bf16_t*)(ws + WS_WOUT), M2, 2048, 2048, nullptr, nullptr}; SchedSplit S; S.full.init(8192, 2048, G, bx, 32); S.rem = SchedRem{32, 8, 8, 4, G, bx};
        pg8::gemm_phase<Epi<F6>, SchedSplit, true, true>(lds, g, S, E);
    }
    xcd_barrier(xb);
    PEND(6);
    PSTART(7);
    if (NGW == 2048) {
        if (gw < 1024) { const int m = 8192 + gw; float* xr = out + O_Y + (size_t)m * 2048; rms_row(xr, P.in[23], Hb + (size_t)m * 2048, nullptr, lane, (const float*)((const bf16_t*)(ws + WS_R) + (size_t)(m - 8192) * 2048), xr); }
        else for (int k = 0; k < 8; ++k) { const int m = (gw - 1024) + 1024 * k; rms_row(out + O_Y + (size_t)m * 2048, P.in[23], Hb + (size_t)m * 2048, nullptr, lane); }
    } else
    for (int m = gw; m < M2; m += NGW) { float* xr = out + O_Y + (size_t)m * 2048;
        if (m < 8192) rms_row(xr, P.in[23], Hb + (size_t)m * 2048, nullptr, lane); else rms_row(xr, P.in[23], Hb + (size_t)m * 2048, nullptr, lane, (const float*)((const bf16_t*)(ws + WS_R) + (size_t)(m - 8192) * 2048), xr); }
    xcd_barrier(xb);
    PEND(7);
    PSTART(8);
    {
        pg8::Gemm g{Hb, (const bf16_t*)(ws + WS_WUP), M2, DFF, 2048, nullptr, nullptr}; pg8::StaticOrder S; S.init(M2, DFF, G, bx, 32);
        Epi<F8> E{F8{(bf16_t*)(ws + WS_ACT)}};
        pg8::gemm_phase<Epi<F8>, pg8::StaticOrder, true, true>(lds, g, S, E);
        convert_tail(P.in[25], DFF, 2048, (bf16_t*)(ws + WS_WDN), DN_P5, 128 * 64, (M2 / 256) * (DFF / 256), G, bx, wave, lane, (LAS float*)(lds + wave * 16384));
    }
    xcd_barrier(xb);
    PEND(8);
    PSTART(9);
    {
        Epi<F9> E{F9{out + O_Y, (float*)(ws + WS_WIN)}};
        pg8::Gemm g{(const bf16_t*)(ws + WS_ACT), (const bf16_t*)(ws + WS_WDN), M2, 2048, DFF, nullptr, nullptr}; SchedSplit S; S.full.init(8192, 2048, G, bx, 128); S.rem = SchedRem{32, 8, 8, 16, G, bx};
        pg8::gemm_phase<Epi<F9>, SchedSplit, true, true>(lds, g, S, E);
    }
    xcd_barrier(xb);
    PEND(9);
    PSTART(10);
    if (NGW == 2048) {
        if (gw < 1024) { const int m = 8192 + gw; float* xr = out + O_Y + (size_t)m * 2048; rms_row(xr, P.in[26], nullptr, xr, lane, (const float*)((const bf16_t*)(ws + WS_WIN) + (size_t)(m - 8192) * 2048), nullptr); }
        else for (int k = 0; k < 8; ++k) { const int m = (gw - 1024) + 1024 * k; float* xr = out + O_Y + (size_t)m * 2048; rms_row(xr, P.in[26], nullptr, xr, lane); }
    } else
    for (int m = gw; m < M2; m += NGW) { float* xr = out + O_Y + (size_t)m * 2048;
        if (m < 8192) rms_row(xr, P.in[26], nullptr, xr, lane); else rms_row(xr, P.in[26], nullptr, xr, lane, (const float*)((const bf16_t*)(ws + WS_WIN) + (size_t)(m - 8192) * 2048), nullptr); }
    if (PROBE) { xcd_barrier(xb); if (PROBE == 11) { pdur = __builtin_amdgcn_s_memrealtime() - pt0; }
        if (bx == 0 && tid == 0) { const unsigned long long t = __builtin_amdgcn_s_memrealtime(); while (__builtin_amdgcn_s_memrealtime() - t < pdur) __builtin_amdgcn_s_sleep(8); } }
}

extern "C" void kernel_launch(void* const* d_in, const int* in_sizes, int n_in, void* d_out, int out_size, void* d_ws, size_t ws_size, hipStream_t stream) {
    static int grid = 0;
    if (grid == 0) {
        if (n_in != 27 || out_size != 28385280 || ws_size < WS_END) { fprintf(stderr, "kernel_launch: unexpected shapes (n_in %d, out %d, ws %zu < %zu)\n", n_in, out_size, ws_size, (size_t)WS_END); grid = -1; return; }
        int dev = 0, cus = 0, per_cu = 0;
        hipGetDevice(&dev); hipDeviceGetAttribute(&cus, hipDeviceAttributeMultiprocessorCount, dev);
        if (hipFuncSetAttribute((const void*)mega_fwd, hipFuncAttributeMaxDynamicSharedMemorySize, LDS_BYTES) != hipSuccess) { fprintf(stderr, "kernel_launch: hipFuncSetAttribute failed\n"); grid = -1; return; }
        if (hipOccupancyMaxActiveBlocksPerMultiprocessor(&per_cu, (const void*)mega_fwd, 512, LDS_BYTES) != hipSuccess || per_cu < 1) { fprintf(stderr, "kernel_launch: occupancy query says %d\n", per_cu); (void)hipGetLastError(); per_cu = 1; }
        grid = cus * per_cu;
    }
    if (grid < 0) return;
    Params p{};
    for (int i = 0; i < 27; ++i) p.in[i] = (const float*)d_in[i];
    p.out = (float*)d_out; p.ws = (unsigned char*)d_ws;
    void* args[] = {&p};
    hipError_t e = hipLaunchCooperativeKernel((const void*)mega_fwd, dim3(grid), dim3(512), args, LDS_BYTES, stream);
    if (e != hipSuccess) fprintf(stderr, "cooperative launch failed: %s (grid %d)\n", hipGetErrorString(e), grid);
}
```
